# Optimizing an MI355X kernel written in HIP

```python
import jax, jax.numpy as jnp
from jax import lax
import numpy as np

D_MODEL = 1024
BATCH = 8
SEQ = 8192
DEPTH = 1
DEC_BATCH = 2
DEC_SEQ = 8192
PAST_LEN = 128

GRID_W = 64
N_HEADS = 8
HEAD_DIM = 64
D_ATTN = N_HEADS * HEAD_DIM
D_CONV = 512
CONV_W = 3
WIN_ROWS_MAX = 8
WIN_COLS = 16
COL_BLOCK = 16
KEY_COL_BLOCK = COL_BLOCK + WIN_COLS
N_COL_BLOCKS = GRID_W // COL_BLOCK
N_BRANCHES = 2
D_IN_PROJ = 3 * D_ATTN + 3 * D_CONV + N_BRANCHES * D_MODEL
D_FF = ((8 * D_MODEL + 3 * 256 - 1) // (3 * 256)) * 256
RMS_EPS = 1e-6
NEG_INF = -1e30

kernel_name = "hybrid_natten_shortconv_encoder"


def rms_norm(x, g):
    xf = x.astype(jnp.float32)
    y = xf * lax.rsqrt(jnp.mean(xf * xf, axis=-1, keepdims=True) + RMS_EPS)
    return (y * g.astype(jnp.float32)).astype(x.dtype)


def neighbourhood_attention(q, k, v, rpb):
    bsz, seq_len, _ = q.shape
    rows = seq_len // GRID_W
    wr = min(WIN_ROWS_MAX, rows)
    qg = q.reshape(bsz, rows, N_COL_BLOCKS, COL_BLOCK, N_HEADS, HEAD_DIM)
    kg = k.reshape(bsz, rows, GRID_W, N_HEADS, HEAD_DIM)
    vg = v.reshape(bsz, rows, GRID_W, N_HEADS, HEAD_DIM)

    j = np.arange(N_COL_BLOCKS)
    kcol = np.clip(j * COL_BLOCK - WIN_COLS // 2, 0, GRID_W - KEY_COL_BLOCK)[:, None] + np.arange(KEY_COL_BLOCK)[None, :]
    qcol = j[:, None] * COL_BLOCK + np.arange(COL_BLOCK)[None, :]
    cstart = np.clip(qcol - WIN_COLS // 2, 0, GRID_W - WIN_COLS)
    valid = (kcol[:, None, :] >= cstart[:, :, None]) & (kcol[:, None, :] < cstart[:, :, None] + WIN_COLS)
    col_idx = np.clip(kcol[:, None, :] - qcol[:, :, None] + WIN_COLS - 1, 0, 2 * WIN_COLS - 2)
    valid = jnp.asarray(valid)
    rpb_cols = rpb[:, :, col_idx]
    scale = HEAD_DIM ** -0.5

    def row_step(r):
        rs = jnp.clip(r - wr // 2, 0, rows - wr)
        qb = lax.dynamic_index_in_dim(qg, r, axis=1, keepdims=False)
        kr = lax.dynamic_slice_in_dim(kg, rs, wr, axis=1)
        vr = lax.dynamic_slice_in_dim(vg, rs, wr, axis=1)
        kb = kr[:, :, kcol]
        vb = vr[:, :, kcol]
        s = jnp.einsum('bjqhd,bwjkhd->bhjqwk', qb, kb).astype(jnp.float32) * scale
        ri = rs + jnp.arange(wr) - r + (WIN_ROWS_MAX - 1)
        bias = jnp.take(rpb_cols, ri, axis=1).transpose(0, 2, 3, 1, 4)
        s = s + bias[None].astype(jnp.float32)
        s = jnp.where(valid[None, None, :, :, None, :], s, NEG_INF)
        sh = s.shape
        p = jax.nn.softmax(s.reshape(sh[:4] + (wr * KEY_COL_BLOCK,)), axis=-1).reshape(sh)
        return jnp.einsum('bhjqwk,bwjkhd->bjqhd', p.astype(v.dtype), vb)

    out = lax.map(row_step, jnp.arange(rows))
    return out.transpose(1, 0, 2, 3, 4, 5).reshape(bsz, seq_len, D_ATTN)


def short_conv(z, w):
    zp = jnp.pad(z, ((0, 0), (1, 1), (0, 0)))
    return zp[:, :-2] * w[0] + zp[:, 1:-1] * w[1] + zp[:, 2:] * w[2]


def mixer(xn, w_in, b_gate, rpb, conv_w, w_attn_branch, w_conv_branch, w_out):
    proj = jnp.einsum('bld,de->ble', xn, w_in)
    splits = np.cumsum([D_ATTN, D_ATTN, D_ATTN, D_CONV, D_CONV, D_CONV])
    q, k, v, u, bg, cg, gl = jnp.split(proj, splits, axis=-1)
    a = neighbourhood_attention(q, k, v, rpb)
    c = bg * short_conv(cg * u, conv_w)
    gates = jax.nn.sigmoid(gl + b_gate)
    g_a, g_c = jnp.split(gates, 2, axis=-1)
    merged = g_a * jnp.einsum('ble,ed->bld', a, w_attn_branch) + g_c * jnp.einsum('ble,ed->bld', c, w_conv_branch)
    return jnp.einsum('bld,de->ble', merged, w_out)


def swiglu(xn, w_ffn_in, w_ffn_down):
    h = jnp.einsum('bld,df->blf', xn, w_ffn_in)
    gate, up = jnp.split(h, 2, axis=-1)
    return jnp.einsum('blf,fd->bld', jax.nn.silu(gate) * up, w_ffn_down)


def trunk(x, norm_mix_g, w_in, b_gate, rpb, conv_w, w_attn_branch, w_conv_branch, w_out,
          norm_ffn_g, w_ffn_in, w_ffn_down, norm_final_g):
    for i in range(DEPTH):
        x = x + mixer(rms_norm(x, norm_mix_g[i]), w_in[i], b_gate[i], rpb[i], conv_w[i],
                      w_attn_branch[i], w_conv_branch[i], w_out[i])
        x = x + swiglu(rms_norm(x, norm_ffn_g[i]), w_ffn_in[i], w_ffn_down[i])
    return rms_norm(x, norm_final_g)


def setup_inputs(seed: int = 0) -> dict:
    key = jax.random.key(seed)
    ks = jax.random.split(key, 16)
    f32 = jnp.float32
    n = lambda k, shape, s: jax.random.normal(k, shape, f32) * s
    return {
        "x_prompt": n(ks[0], (BATCH, SEQ, D_MODEL), 1.0),
        "x_sample": n(ks[1], (DEC_BATCH, DEC_SEQ, D_MODEL), 1.0),
        "norm_mix_g": 1.0 + n(ks[2], (DEPTH, D_MODEL), 0.02),
        "w_in": n(ks[3], (DEPTH, D_MODEL, D_IN_PROJ), D_MODEL ** -0.5),
        "b_gate": n(ks[4], (DEPTH, N_BRANCHES * D_MODEL), 0.02),
        "rpb": n(ks[5], (DEPTH, N_HEADS, 2 * WIN_ROWS_MAX - 1, 2 * WIN_COLS - 1), 0.5),
        "conv_w": n(ks[6], (DEPTH, CONV_W, D_CONV), CONV_W ** -0.5),
        "w_attn_branch": n(ks[7], (DEPTH, D_ATTN, D_MODEL), D_ATTN ** -0.5),
        "w_conv_branch": n(ks[8], (DEPTH, D_CONV, D_MODEL), D_CONV ** -0.5),
        "w_out": n(ks[9], (DEPTH, D_MODEL, D_MODEL), D_MODEL ** -0.5),
        "norm_ffn_g": 1.0 + n(ks[10], (DEPTH, D_MODEL), 0.02),
        "w_ffn_in": n(ks[11], (DEPTH, D_MODEL, 2 * D_FF), D_MODEL ** -0.5),
        "w_ffn_down": n(ks[12], (DEPTH, D_FF, D_MODEL), D_FF ** -0.5),
        "norm_final_g": 1.0 + n(ks[13], (D_MODEL,), 0.02),
    }


def reference(x_prompt, x_sample, norm_mix_g, w_in, b_gate, rpb, conv_w, w_attn_branch,
              w_conv_branch, w_out, norm_ffn_g, w_ffn_in, w_ffn_down, norm_final_g):
    y_prompt = trunk(x_prompt, norm_mix_g, w_in, b_gate, rpb, conv_w, w_attn_branch, w_conv_branch,
                     w_out, norm_ffn_g, w_ffn_in, w_ffn_down, norm_final_g)
    y_sample = trunk(x_sample, norm_mix_g, w_in, b_gate, rpb, conv_w, w_attn_branch, w_conv_branch,
                     w_out, norm_ffn_g, w_ffn_in, w_ffn_down, norm_final_g)
    return (y_prompt, y_sample)
```

```cpp
#include <hip/hip_runtime.h>
#include <hip/hip_cooperative_groups.h>
#include <cstdio>
#include <cstdint>
namespace cg = cooperative_groups;

#define DI __device__ __forceinline__
#define LAS __attribute__((address_space(3)))
typedef unsigned short bf16_t;
typedef short bf16x8 __attribute__((ext_vector_type(8)));
typedef short s16x4 __attribute__((ext_vector_type(4)));
typedef float f32x4 __attribute__((ext_vector_type(4)));
typedef float f32x2 __attribute__((ext_vector_type(2)));
typedef unsigned u32x4 __attribute__((ext_vector_type(4)));
typedef unsigned u32x2 __attribute__((ext_vector_type(2)));
typedef __bf16 bf16x2n __attribute__((ext_vector_type(2)));

constexpr int M = 81920, MP = 65536, D = 1024, DA = 512, DFF = 2816, SEQ = 8192;
constexpr int NIN = 5120, NMAIN = 4608;
constexpr float RMS_EPS = 1e-6f, LOG2E = 1.4426950408889634f;
constexpr float QSCALE = 0.125f * LOG2E;
constexpr size_t MiB = 1u << 20;
constexpr size_t WS_WIN = 1 * MiB, WS_WA = 11 * MiB, WS_WC = 12 * MiB, WS_WOUT = 13 * MiB, WS_WFI = 15 * MiB, WS_WFD = 26 * MiB;
constexpr size_t WS_RSQ1 = 32 * MiB, WS_RSQ2 = 38 * MiB;
constexpr size_t WS_G = 44 * MiB, WS_Q = 364 * MiB, WS_K = 444 * MiB, WS_VT = 524 * MiB, WS_UBC = 604 * MiB, WS_XN = 844 * MiB;
constexpr size_t WS_AC = WS_XN, WS_MG = WS_Q, WS_X1B = WS_VT, WS_ACT = WS_G, WS_END = 1004 * MiB;
constexpr int LDS_BYTES = 135168;

DI unsigned pk2(float lo, float hi) { f32x2 v = {lo, hi}; return __builtin_bit_cast(unsigned, __builtin_convertvector(v, bf16x2n)); }
DI float bf_lo(unsigned w) { return __uint_as_float(w << 16); }
DI float bf_hi(unsigned w) { return __uint_as_float(w & 0xffff0000u); }
DI float fast_sigmoid(float v) { return __builtin_amdgcn_rcpf(1.0f + __builtin_amdgcn_exp2f(-v * LOG2E)); }

namespace pg8 {
constexpr int BM = 256, BK = 64, HALF = 128, HTB = HALF * BK * 2, STAGE_BYTES = 8 * HTB, NXCD = 8, WGM = 8;
DI int lds_byte(int r, int c) { const int st = (r >> 4) * 2 + (c >> 5), rr = r & 15, cc = c & 31, ob = rr * 64 + cc * 2; return st * 1024 + (ob ^ (((ob >> 9) & 1) << 5)); }
DI void stage_rc(int b, int& R, int& C) { const int st = b / 1024, sb = b % 1024, swz = sb ^ (((sb >> 9) & 1) << 5); R = (st >> 1) * 16 + swz / 64; C = (st & 1) * 32 + (swz % 64) / 2; }
DI int perm32(int rho) { const int n = rho >> 4, i = rho & 15; return 8 * (i >> 2) + 4 * n + (i & 3); }

struct Unit { int pm, pn; };
struct Gemm { const bf16_t* A; const bf16_t* Bt; int M, N, K, lda; };

struct StaticOrder {
    int nM, nN, nwg, G, c;
    DI void init(int M_, int N_, int G_, int c_) { nM = M_ / BM; nN = N_ / BM; nwg = nM * nN; G = G_; c = c_; }
    DI bool next(int i, Unit& u) const {
        const long L = (long)i * G + c; if (L >= nwg) return false;
        int wgid = (int)L; { const int q = nwg / NXCD, r = nwg % NXCD, xcd = wgid % NXCD, off = wgid / NXCD; wgid = (xcd < r ? xcd * (q + 1) : r * (q + 1) + (xcd - r) * q) + off; }
        const int nig = WGM * nN, gid = wgid / nig, fm = gid * WGM, gsz = (nM - fm) < WGM ? (nM - fm) : WGM;
        u.pm = fm + ((wgid % nig) % gsz); u.pn = (wgid % nig) / gsz; return true;
    }
};

template <class Epi, class Sched, bool ALIGN_EPI>
DI void gemm_phase(LAS unsigned char* lds, const Gemm g, const Sched& S, const Epi& E) {
    const int tid = threadIdx.x, wid = __builtin_amdgcn_readfirstlane(tid >> 6), lane = tid & 63, wr = wid >> 2, wc = wid & 3, fr = lane & 15, fq = lane >> 4;
    const int K = g.K, nt = K / BK, lda = g.lda;
    unsigned voffA[2], voffB[2];
#pragma unroll
    for (int i = 0; i < 2; ++i) { int R, C; stage_rc(tid * 16 + i * 8192, R, C); const int Rb = Epi::PERM ? ((R & ~31) + perm32(R & 31)) : R;
        voffA[i] = (unsigned)(R * lda + C) * 2u; voffB[i] = (unsigned)(Rb * K + C) * 2u; }
    const size_t kstep = (size_t)(BK * 2);
    const size_t hstepA = (size_t)HALF * lda * 2, hstepB = (size_t)HALF * K * 2;
    const size_t tstepA = 2 * hstepA, tstepB = 2 * hstepB;
    const unsigned ldsw = (unsigned)wid * 1024u;
    const int aoff = lds_byte(wr * 64 + fr, fq * 8), boff = lds_byte(wc * 32 + fr, fq * 8);
#define PG8_SA(b, h) (((b) * 2 + (h)) * HTB)
#define PG8_SB(b, h) ((4 + (b) * 2 + (h)) * HTB)
#define PG8_STAGE(bufoff, gbase, voff) do { _Pragma("unroll") for (int _i = 0; _i < 2; ++_i) \
        __builtin_amdgcn_global_load_lds((const unsigned*)((const char*)(gbase) + (voff)[_i]), (LAS unsigned*)(lds + (bufoff) + ldsw + _i * 8192), 16, 0, 0); } while (0)
#define PG8_LDA(dst, b, h) do { _Pragma("unroll") for (int m = 0; m < 4; ++m) _Pragma("unroll") for (int k = 0; k < 2; ++k) dst[m][k] = *(const LAS bf16x8*)(lds + PG8_SA(b, h) + aoff + m * 2048 + k * 1024); } while (0)
#define PG8_LDB(dst, b, h) do { _Pragma("unroll") for (int n = 0; n < 2; ++n) _Pragma("unroll") for (int k = 0; k < 2; ++k) dst[n][k] = *(const LAS bf16x8*)(lds + PG8_SB(b, h) + boff + n * 2048 + k * 1024); } while (0)
#define PG8_MMA(ai, bj, At, Bt) do { __builtin_amdgcn_s_setprio(1); _Pragma("unroll") for (int m = 0; m < 4; ++m) _Pragma("unroll") for (int n = 0; n < 2; ++n) _Pragma("unroll") for (int k = 0; k < 2; ++k) \
        acc[ai][bj][m][n] = __builtin_amdgcn_mfma_f32_16x16x32_bf16(Bt[n][k], At[m][k], acc[ai][bj][m][n], 0, 0, 0); __builtin_amdgcn_s_setprio(0); } while (0)
#define PG8_WAIT_V(n) asm volatile("s_waitcnt vmcnt(" #n ")" ::: "memory")
#define PG8_WAIT_L(n) asm volatile("s_waitcnt lgkmcnt(" #n ")" ::: "memory")
#define PG8_BAR __builtin_amdgcn_s_barrier()
#define PG8_SCHED __builtin_amdgcn_sched_barrier(0)
    Unit cur, nxt; int ui = 0;
    if (!S.next(0, cur)) return;
    f32x4 acc[2][2][4][2];
#pragma unroll
    for (int a = 0; a < 2; ++a)
#pragma unroll
        for (int b = 0; b < 2; ++b)
#pragma unroll
            for (int m = 0; m < 4; ++m)
#pragma unroll
                for (int n = 0; n < 2; ++n) acc[a][b][m][n] = (f32x4){0.f, 0.f, 0.f, 0.f};
    bf16x8 At[4][2], B0[2][2], B1[2][2];
    const char* cA = (const char*)g.A + (size_t)cur.pm * tstepA; const char* cB = (const char*)g.Bt + (size_t)cur.pn * tstepB;
    PG8_STAGE(PG8_SB(0, 0), cB, voffB); PG8_STAGE(PG8_SB(0, 1), cB + hstepB, voffB); PG8_STAGE(PG8_SA(0, 0), cA, voffA); PG8_STAGE(PG8_SA(0, 1), cA + hstepA, voffA);
    if (wr == 1) PG8_BAR;
    PG8_WAIT_V(2); PG8_BAR;
    PG8_STAGE(PG8_SB(1, 0), cB + kstep, voffB); PG8_STAGE(PG8_SA(1, 0), cA + kstep, voffA); PG8_STAGE(PG8_SB(1, 1), cB + hstepB + kstep, voffB);
    PG8_WAIT_V(6); PG8_BAR;
    for (;;) {
        const bool has_next = S.next(ui + 1, nxt);
        const char* nA = has_next ? (const char*)g.A + (size_t)nxt.pm * tstepA : cA; const char* nB = has_next ? (const char*)g.Bt + (size_t)nxt.pn * tstepB : cB;
        for (int t = 0; t < nt; t += 2) {
            const bool last = (t == nt - 2);
            const char* a1 = cA + (size_t)(t + 1) * kstep;
            const char* a2 = last ? nA : cA + (size_t)(t + 2) * kstep; const char* b2 = last ? nB : cB + (size_t)(t + 2) * kstep;
            const char* a3 = a2 + kstep; const char* b3 = b2 + kstep;
            PG8_LDB(B0, 0, 0); PG8_LDB(B1, 0, 1); PG8_SCHED; PG8_LDA(At, 0, 0); PG8_STAGE(PG8_SA(1, 1), a1 + hstepA, voffA);
            PG8_WAIT_V(8); PG8_WAIT_L(0); PG8_BAR; PG8_MMA(0, 0, At, B0); PG8_MMA(0, 1, At, B1); PG8_BAR; PG8_SCHED;
            PG8_LDA(At, 0, 1); PG8_STAGE(PG8_SB(0, 0), b2, voffB); PG8_STAGE(PG8_SB(0, 1), b2 + hstepB, voffB); PG8_STAGE(PG8_SA(0, 0), a2, voffA);
            PG8_WAIT_V(8); PG8_WAIT_L(0); PG8_BAR; PG8_MMA(1, 0, At, B0); PG8_MMA(1, 1, At, B1); PG8_BAR; PG8_SCHED;
            PG8_LDB(B0, 1, 0); PG8_LDB(B1, 1, 1); PG8_SCHED; PG8_LDA(At, 1, 0); PG8_STAGE(PG8_SA(0, 1), a2 + hstepA, voffA);
            PG8_WAIT_V(8); PG8_WAIT_L(0); PG8_BAR; PG8_MMA(0, 0, At, B0); PG8_MMA(0, 1, At, B1); PG8_BAR; PG8_SCHED;
            PG8_LDA(At, 1, 1); PG8_STAGE(PG8_SB(1, 0), b3, voffB); PG8_STAGE(PG8_SB(1, 1), b3 + hstepB, voffB); PG8_STAGE(PG8_SA(1, 0), a3, voffA);
            PG8_WAIT_V(8); PG8_WAIT_L(0); PG8_BAR; PG8_MMA(1, 0, At, B0); PG8_MMA(1, 1, At, B1); PG8_BAR; PG8_SCHED;
        }
        if constexpr (ALIGN_EPI) { if (wr == 0) PG8_BAR; }
        E(acc, cur, wr, wc, fr, fq);
        if (!has_next) break;
#pragma unroll
        for (int a = 0; a < 2; ++a)
#pragma unroll
            for (int b = 0; b < 2; ++b)
#pragma unroll
                for (int m = 0; m < 4; ++m)
#pragma unroll
                    for (int n = 0; n < 2; ++n) acc[a][b][m][n] = (f32x4){0.f, 0.f, 0.f, 0.f};
        cur = nxt; cA = nA; cB = nB; ++ui;
        if constexpr (ALIGN_EPI) { if (wr == 1) PG8_BAR; }
    }
    PG8_WAIT_V(0);
    if constexpr (!ALIGN_EPI) { if (wr == 0) PG8_BAR; }
    PG8_BAR;
#undef PG8_SA
#undef PG8_SB
#undef PG8_STAGE
#undef PG8_LDA
#undef PG8_LDB
#undef PG8_MMA
#undef PG8_WAIT_V
#undef PG8_WAIT_L
#undef PG8_BAR
#undef PG8_SCHED
}
}
using pg8::Unit;

struct EpiProj {
    static constexpr bool PERM = true;
    bf16_t *Q, *K, *UBC, *G; const float* bgate;
    DI void operator()(const f32x4 (&acc)[2][2][4][2], const Unit& u, int wr, int wc, int fr, int fq) const {
        const int row0 = u.pm * 256 + wr * 64 + fr, cl = wc * 32 + 8 * fq, pn = u.pn;
        bf16_t* base; int ld; float sc = 1.f; bool gate = false; int gcol = 0;
        if (pn < 2) { base = Q + pn * 256; ld = 512; sc = QSCALE; }
        else if (pn < 4) { base = K + (pn - 2) * 256; ld = 512; }
        else if (pn < 10) { base = UBC + (pn - 4) * 256; ld = 1536; }
        else { base = G + (pn - 10) * 256; ld = 2048; gate = true; gcol = (pn - 10) * 256; }
        f32x4 bv[2][2];
#pragma unroll
        for (int bj = 0; bj < 2; ++bj)
#pragma unroll
            for (int n = 0; n < 2; ++n) bv[bj][n] = gate ? *(const f32x4*)(bgate + gcol + cl + bj * 128 + 4 * n) : (f32x4){0.f, 0.f, 0.f, 0.f};
#pragma unroll
        for (int ai = 0; ai < 2; ++ai)
#pragma unroll
            for (int m = 0; m < 4; ++m) { bf16_t* rowp = base + (size_t)(row0 + ai * 128 + m * 16) * ld + cl;
#pragma unroll
                for (int bj = 0; bj < 2; ++bj) { f32x4 v0 = acc[ai][bj][m][0] + bv[bj][0], v1 = acc[ai][bj][m][1] + bv[bj][1];
                    if (gate) {
#pragma unroll
                        for (int e = 0; e < 4; ++e) { v0[e] = fast_sigmoid(v0[e]); v1[e] = fast_sigmoid(v1[e]); }
                    } else { v0 = v0 * sc; v1 = v1 * sc; }
                    u32x4 w; w.x = pk2(v0[0], v0[1]); w.y = pk2(v0[2], v0[3]); w.z = pk2(v1[0], v1[1]); w.w = pk2(v1[2], v1[3]);
                    *(u32x4*)(rowp + bj * 128) = w; } }
    }
};
struct EpiVT {
    static constexpr bool PERM = true;
    bf16_t* VT;
    DI void operator()(const f32x4 (&acc)[2][2][4][2], const Unit& u, int wr, int wc, int fr, int fq) const {
        const int ch0 = u.pm * 256 + wr * 64 + fr, tokl = u.pn * 256 + wc * 32 + 8 * fq;
#pragma unroll
        for (int ai = 0; ai < 2; ++ai)
#pragma unroll
            for (int m = 0; m < 4; ++m) { const int ch = ch0 + ai * 128 + m * 16, h = ch >> 6, d = ch & 63;
#pragma unroll
                for (int bj = 0; bj < 2; ++bj) { const int tok = tokl + bj * 128, b = tok >> 13, t = tok & 8191, row = t >> 6, col = t & 63;
                    const f32x4 v0 = acc[ai][bj][m][0], v1 = acc[ai][bj][m][1];
                    u32x4 w; w.x = pk2(v0[0], v0[1]); w.y = pk2(v0[2], v0[3]); w.z = pk2(v1[0], v1[1]); w.w = pk2(v1[2], v1[3]);
                    *(u32x4*)(VT + ((((size_t)(b * 8 + h) * 128 + row) * 64 + d) * 64 + col)) = w; } }
    }
};
struct EpiBranch {
    static constexpr bool PERM = true;
    bf16_t* MG; const bf16_t* G; int second;
    DI void operator()(const f32x4 (&acc)[2][2][4][2], const Unit& u, int wr, int wc, int fr, int fq) const {
        const int row0 = u.pm * 256 + wr * 64 + fr, c0 = u.pn * 256 + wc * 32 + 8 * fq;
#pragma unroll
        for (int ai = 0; ai < 2; ++ai)
#pragma unroll
            for (int m = 0; m < 4; ++m) { const size_t row = (size_t)(row0 + ai * 128 + m * 16);
#pragma unroll
                for (int bj = 0; bj < 2; ++bj) { const int c = c0 + bj * 128;
                    const u32x4 gw = *(const u32x4*)(G + row * 2048 + second * 1024 + c);
                    f32x4 v0 = acc[ai][bj][m][0], v1 = acc[ai][bj][m][1];
                    v0[0] *= bf_lo(gw.x); v0[1] *= bf_hi(gw.x); v0[2] *= bf_lo(gw.y); v0[3] *= bf_hi(gw.y);
                    v1[0] *= bf_lo(gw.z); v1[1] *= bf_hi(gw.z); v1[2] *= bf_lo(gw.w); v1[3] *= bf_hi(gw.w);
                    u32x4* dst = (u32x4*)(MG + row * 1024 + c);
                    if (second) { const u32x4 o = *dst;
                        v0[0] += bf_lo(o.x); v0[1] += bf_hi(o.x); v0[2] += bf_lo(o.y); v0[3] += bf_hi(o.y);
                        v1[0] += bf_lo(o.z); v1[1] += bf_hi(o.z); v1[2] += bf_lo(o.w); v1[3] += bf_hi(o.w); }
                    u32x4 w; w.x = pk2(v0[0], v0[1]); w.y = pk2(v0[2], v0[3]); w.z = pk2(v1[0], v1[1]); w.w = pk2(v1[2], v1[3]);
                    *dst = w; } }
    }
};
struct EpiResid {
    static constexpr bool PERM = false;
    const float* xp; const float* xs; float* out; bf16_t* XB; float* RSQ; int inplace;
    DI void operator()(const f32x4 (&acc)[2][2][4][2], const Unit& u, int wr, int wc, int fr, int fq) const {
        const int row0 = u.pm * 256 + wr * 64 + fr, c0 = u.pn * 256 + wc * 32 + 4 * fq;
#pragma unroll
        for (int ai = 0; ai < 2; ++ai)
#pragma unroll
            for (int m = 0; m < 4; ++m) { const int row = row0 + ai * 128 + m * 16;
                const float* bp = inplace ? out + (size_t)row * 1024 : (row < MP ? xp + (size_t)row * 1024 : xs + (size_t)(row - MP) * 1024);
                float ss = 0.f;
#pragma unroll
                for (int bj = 0; bj < 2; ++bj)
#pragma unroll
                    for (int n = 0; n < 2; ++n) { const int c = c0 + bj * 128 + n * 16;
                        const f32x4 o = *(const f32x4*)(bp + c) + acc[ai][bj][m][n];
                        *(f32x4*)(out + (size_t)row * 1024 + c) = o;
                        if (XB) { u32x2 w; w.x = pk2(o[0], o[1]); w.y = pk2(o[2], o[3]); *(u32x2*)(XB + (size_t)row * 1024 + c) = w; }
                        ss += (o[0] * o[0] + o[1] * o[1]) + (o[2] * o[2] + o[3] * o[3]); }
                ss += __shfl_xor(ss, 16); ss += __shfl_xor(ss, 32);
                if (fq == 0) RSQ[(size_t)row * 16 + u.pn * 4 + wc] = ss; }
    }
};
struct EpiFfnIn {
    static constexpr bool PERM = true;
    bf16_t* ACT; const float* RSQ;
    DI void operator()(const f32x4 (&acc)[2][2][4][2], const Unit& u, int wr, int wc, int fr, int fq) const {
        const int row0 = u.pm * 256 + wr * 64 + fr, c0 = u.pn * 128 + wc * 32 + 8 * fq;
#pragma unroll
        for (int ai = 0; ai < 2; ++ai)
#pragma unroll
            for (int m = 0; m < 4; ++m) { const size_t row = (size_t)(row0 + ai * 128 + m * 16);
                const f32x4 pr = *(const f32x4*)(RSQ + row * 16 + 4 * fq);
                float s = (pr[0] + pr[1]) + (pr[2] + pr[3]); s += __shfl_xor(s, 16); s += __shfl_xor(s, 32);
                const float rs = 1.0f / sqrtf(s * (1.0f / 1024.0f) + RMS_EPS);
                float o[8];
#pragma unroll
                for (int n = 0; n < 2; ++n)
#pragma unroll
                    for (int e = 0; e < 4; ++e) { const float gt = acc[ai][0][m][n][e] * rs, up = acc[ai][1][m][n][e] * rs; o[4 * n + e] = gt * fast_sigmoid(gt) * up; }
                u32x4 w; w.x = pk2(o[0], o[1]); w.y = pk2(o[2], o[3]); w.z = pk2(o[4], o[5]); w.w = pk2(o[6], o[7]);
                *(u32x4*)(ACT + row * DFF + c0) = w; }
    }
};

DI float wave_sum(float v) {
#pragma unroll
    for (int o = 1; o < 64; o <<= 1) v += __shfl_xor(v, o);
    return v;
}
DI void transpose_item(const float* W, int K, int N, int srccol0, const float* ks, bf16_t* WT, int dstrow0, int kb, LAS float* scr, int lane) {
    const int k0 = 64 * kb;
#pragma unroll 8
    for (int i = 0; i < 32; ++i) { const int kk = 2 * i + (lane >> 5); float v = W[(size_t)(k0 + kk) * N + srccol0 + (lane & 31)]; if (ks) v *= ks[k0 + kk]; scr[kk * 33 + (lane & 31)] = v; }
    asm volatile("s_waitcnt lgkmcnt(0)" ::: "memory");
    const int c = lane & 7;
#pragma unroll
    for (int j = 0; j < 4; ++j) { const int n = (lane >> 3) + 8 * j; const LAS float* s = scr + (8 * c) * 33 + n;
        u32x4 o; o.x = pk2(s[0 * 33], s[1 * 33]); o.y = pk2(s[2 * 33], s[3 * 33]); o.z = pk2(s[4 * 33], s[5 * 33]); o.w = pk2(s[6 * 33], s[7 * 33]);
        *(u32x4*)(WT + (size_t)(dstrow0 + n) * K + k0 + 8 * c) = o; }
    asm volatile("s_waitcnt lgkmcnt(0)" ::: "memory");
}

struct Params { const float* in[14]; float* out; unsigned char* ws; int ph_lo, ph_hi; };

DI void p0_prologue(const Params& p, LAS unsigned char* lds, int gw, int NGW, int wave, int lane) {
    unsigned char* ws = p.ws;
    LAS float* scr = (LAS float*)(lds + wave * 16384);
    const float *w_in = p.in[3], *wa = p.in[7], *wc = p.in[8], *wout = p.in[9], *gffn = p.in[10], *wfi = p.in[11], *wfd = p.in[12];
    constexpr int I_IN = 16 * (NIN / 32), I_A = 8 * 32, I_C = 8 * 32, I_O = 16 * 32, I_FI = 16 * (2 * DFF / 32), I_FD = (DFF / 64) * 32;
    constexpr int NITEMS = I_IN + I_A + I_C + I_O + I_FI + I_FD;
    for (int it = gw; it < NITEMS; it += NGW) {
        int r = it;
        if (r < I_IN) { const int nblk = NIN / 32, kb = r / nblk, n0 = 32 * (r % nblk);
            const int src = n0 < 1024 ? n0 : (n0 < NMAIN ? n0 + 512 : n0 - NMAIN + 1024);
            transpose_item(w_in, D, NIN, src, nullptr, (bf16_t*)(ws + WS_WIN), n0, kb, scr, lane); continue; } r -= I_IN;
        if (r < I_A) { transpose_item(wa, DA, D, 32 * (r % 32), nullptr, (bf16_t*)(ws + WS_WA), 32 * (r % 32), r / 32, scr, lane); continue; } r -= I_A;
        if (r < I_C) { transpose_item(wc, DA, D, 32 * (r % 32), nullptr, (bf16_t*)(ws + WS_WC), 32 * (r % 32), r / 32, scr, lane); continue; } r -= I_C;
        if (r < I_O) { transpose_item(wout, D, D, 32 * (r % 32), nullptr, (bf16_t*)(ws + WS_WOUT), 32 * (r % 32), r / 32, scr, lane); continue; } r -= I_O;
        if (r < I_FI) { const int nblk = 2 * DFF / 32, kb = r / nblk, n0 = 32 * (r % nblk);
            const int pn = n0 >> 8, within = n0 & 255, src = (within >> 7) * DFF + 128 * pn + (within & 127);
            transpose_item(wfi, D, 2 * DFF, src, gffn, (bf16_t*)(ws + WS_WFI), n0, kb, scr, lane); continue; } r -= I_FI;
        transpose_item(wfd, DFF, D, 32 * (r % 32), nullptr, (bf16_t*)(ws + WS_WFD), 32 * (r % 32), r / 32, scr, lane);
    }
    const float* gm = p.in[2];
    bf16_t* XN = (bf16_t*)(ws + WS_XN);
    f32x4 gv[4];
#pragma unroll
    for (int j = 0; j < 4; ++j) gv[j] = *((const f32x4*)gm + lane + 64 * j);
    for (int row = gw; row < M; row += NGW) {
        const float* xrow = row < MP ? p.in[0] + (size_t)row * D : p.in[1] + (size_t)(row - MP) * D;
        const f32x4* xr = (const f32x4*)xrow + lane;
        f32x4 v[4]; float s = 0.f;
#pragma unroll
        for (int j = 0; j < 4; ++j) { v[j] = xr[64 * j]; s += (v[j][0] * v[j][0] + v[j][1] * v[j][1]) + (v[j][2] * v[j][2] + v[j][3] * v[j][3]); }
        const float rs = 1.0f / sqrtf(wave_sum(s) * (1.0f / D) + RMS_EPS);
        u32x2* o8 = (u32x2*)(XN + (size_t)row * D) + lane;
#pragma unroll
        for (int j = 0; j < 4; ++j) { const f32x4 y = v[j] * rs * gv[j]; u32x2 w; w.x = pk2(y[0], y[1]); w.y = pk2(y[2], y[3]); o8[64 * j] = w; }
    }
}

constexpr int TAB_PAD = 64;
DI void p2_attention(const Params& p, LAS unsigned char* lds, int tid, int wave, int lane, int G, int bx) {
    unsigned char* ws = p.ws;
    const bf16_t* Q = (const bf16_t*)(ws + WS_Q); const bf16_t* Kb = (const bf16_t*)(ws + WS_K); const bf16_t* VT = (const bf16_t*)(ws + WS_VT);
    bf16_t* AC = (bf16_t*)(ws + WS_AC);
    const float* rpb = p.in[5];
    LAS float* tab = (LAS float*)lds + TAB_PAD;
    for (int i = tid; i < 8 * 15 * 32 + 2 * TAB_PAD; i += 512) { const int k = i - TAB_PAD; float v = 0.f;
        if (k >= 0 && k < 8 * 15 * 32) { const int h = k / 480, rem = k % 480, ri = rem >> 5, ci = rem & 31; if (ci < 31) v = rpb[(h * 15 + ri) * 31 + ci] * LOG2E; }
        ((LAS float*)lds)[i] = v; }
    __syncthreads();
    const int qi = lane & 15, mq = lane >> 4;
    constexpr int NUNITS = 10 * 8 * 16;
    const int per = (NUNITS + G - 1) / G;
    const int j = wave & 3;
    const int kcol0 = j == 0 ? 0 : (j == 1 ? 8 : (j == 2 ? 24 : 32));
    const int qcol = 16 * j + qi;
    int cstart = qcol - 8; cstart = cstart < 0 ? 0 : (cstart > 48 ? 48 : cstart);
    const int t0 = kcol0 + 4 * mq - cstart;
    bool v0[4];
#pragma unroll
    for (int e = 0; e < 4; ++e) v0[e] = (t0 + e >= 0);
    const int cidx0 = kcol0 + 4 * mq - qcol + 15;
    for (int un = bx * per; un < (bx + 1) * per && un < NUNITS; ++un) {
        const int bh = un >> 4, band = un & 15, b = bh >> 3, h = bh & 7;
        for (int it = 0; it < 4; ++it) {
            const int r = band * 8 + it * 2 + (wave >> 2);
            int rs = r - 4; rs = rs < 0 ? 0 : (rs > 120 ? 120 : rs);
            const size_t qtok = (size_t)b * SEQ + r * 64 + qcol;
            bf16x8 qf[2];
#pragma unroll
            for (int ks = 0; ks < 2; ++ks) qf[ks] = *(const bf16x8*)(Q + qtok * 512 + h * 64 + ks * 32 + mq * 8);
            f32x4 s[8][2];
#pragma unroll
            for (int w = 0; w < 8; ++w) {
                const size_t ktok = (size_t)b * SEQ + (rs + w) * 64 + kcol0 + qi;
#pragma unroll
                for (int cb = 0; cb < 2; ++cb) {
                    const bf16_t* kp = Kb + (ktok + 16 * cb) * 512 + h * 64 + mq * 8;
                    const bf16x8 k0 = *(const bf16x8*)kp, k1 = *(const bf16x8*)(kp + 32);
                    f32x4 a = __builtin_amdgcn_mfma_f32_16x16x32_bf16(k0, qf[0], (f32x4){0.f, 0.f, 0.f, 0.f}, 0, 0, 0);
                    s[w][cb] = __builtin_amdgcn_mfma_f32_16x16x32_bf16(k1, qf[1], a, 0, 0, 0);
                }
            }
            const LAS float* tb = tab + h * 480 + (rs - r + 7) * 32 + cidx0;
            float mx = -1e30f;
#pragma unroll
            for (int w = 0; w < 8; ++w)
#pragma unroll
                for (int cb = 0; cb < 2; ++cb)
#pragma unroll
                    for (int e = 0; e < 4; ++e) { const bool ok = cb == 0 ? v0[e] : !v0[e];
                        const float x = ok ? s[w][cb][e] + tb[32 * w + 16 * cb + e] : -1e30f; s[w][cb][e] = x; mx = fmaxf(mx, x); }
            mx = fmaxf(mx, __shfl_xor(mx, 16)); mx = fmaxf(mx, __shfl_xor(mx, 32));
            float sum = 0.f;
#pragma unroll
            for (int w = 0; w < 8; ++w)
#pragma unroll
                for (int cb = 0; cb < 2; ++cb)
#pragma unroll
                    for (int e = 0; e < 4; ++e) { const float pe = __builtin_amdgcn_exp2f(s[w][cb][e] - mx); s[w][cb][e] = pe; sum += pe; }
            sum += __shfl_xor(sum, 16); sum += __shfl_xor(sum, 32);
            const float inv = 1.0f / sum;
            f32x4 o[4];
#pragma unroll
            for (int db = 0; db < 4; ++db) o[db] = (f32x4){0.f, 0.f, 0.f, 0.f};
            const bf16_t* vbase = VT + ((size_t)(b * 8 + h) * 128 + rs) * 4096 + qi * 64 + kcol0 + 4 * mq;
#pragma unroll
            for (int w = 0; w < 8; ++w) {
                u32x4 pw; pw.x = pk2(s[w][0][0], s[w][0][1]); pw.y = pk2(s[w][0][2], s[w][0][3]); pw.z = pk2(s[w][1][0], s[w][1][1]); pw.w = pk2(s[w][1][2], s[w][1][3]);
                const bf16x8 pf = __builtin_bit_cast(bf16x8, pw);
#pragma unroll
                for (int db = 0; db < 4; ++db) {
                    const bf16_t* vp = vbase + (size_t)w * 4096 + db * 16 * 64;
                    const u32x2 lo = *(const u32x2*)vp, hi = *(const u32x2*)(vp + 16);
                    u32x4 vw; vw.x = lo.x; vw.y = lo.y; vw.z = hi.x; vw.w = hi.y;
                    o[db] = __builtin_amdgcn_mfma_f32_16x16x32_bf16(__builtin_bit_cast(bf16x8, vw), pf, o[db], 0, 0, 0);
                }
            }
#pragma unroll
            for (int db = 0; db < 4; ++db) { const f32x4 y = o[db] * inv; u32x2 w; w.x = pk2(y[0], y[1]); w.y = pk2(y[2], y[3]);
                *(u32x2*)(AC + qtok * 1024 + h * 64 + db * 16 + 4 * mq) = w; }
        }
    }
}
DI void p2_conv(const Params& p, int gtid, int nthreads) {
    unsigned char* ws = p.ws;
    const bf16_t* UBC = (const bf16_t*)(ws + WS_UBC); bf16_t* AC = (bf16_t*)(ws + WS_AC);
    const float* cw = p.in[6];
    for (int idx = gtid; idx < M * 64; idx += nthreads) {
        const int tok = idx >> 6, c8 = (idx & 63) * 8, t = tok & (SEQ - 1);
        const bf16_t* rp = UBC + (size_t)tok * 1536 + c8;
        const u32x4 zero = {0u, 0u, 0u, 0u};
        const u32x4 u1 = *(const u32x4*)rp, g1 = *(const u32x4*)(rp + 1024), bg = *(const u32x4*)(rp + 512);
        const u32x4 u0 = t > 0 ? *(const u32x4*)(rp - 1536) : zero, g0 = t > 0 ? *(const u32x4*)(rp - 1536 + 1024) : zero;
        const u32x4 u2 = t < SEQ - 1 ? *(const u32x4*)(rp + 1536) : zero, g2 = t < SEQ - 1 ? *(const u32x4*)(rp + 1536 + 1024) : zero;
        const f32x4 w0a = *(const f32x4*)(cw + c8), w0b = *(const f32x4*)(cw + c8 + 4), w1a = *(const f32x4*)(cw + 512 + c8), w1b = *(const f32x4*)(cw + 512 + c8 + 4),
                    w2a = *(const f32x4*)(cw + 1024 + c8), w2b = *(const f32x4*)(cw + 1024 + c8 + 4);
        float o[8];
#pragma unroll
        for (int e = 0; e < 4; ++e) {
            const float wl0 = e < 2 ? w0a[2 * e] : w0b[2 * e - 4], wh0 = e < 2 ? w0a[2 * e + 1] : w0b[2 * e - 3];
            const float wl1 = e < 2 ? w1a[2 * e] : w1b[2 * e - 4], wh1 = e < 2 ? w1a[2 * e + 1] : w1b[2 * e - 3];
            const float wl2 = e < 2 ? w2a[2 * e] : w2b[2 * e - 4], wh2 = e < 2 ? w2a[2 * e + 1] : w2b[2 * e - 3];
            o[2 * e]     = bf_lo(bg[e]) * (wl0 * bf_lo(u0[e]) * bf_lo(g0[e]) + wl1 * bf_lo(u1[e]) * bf_lo(g1[e]) + wl2 * bf_lo(u2[e]) * bf_lo(g2[e]));
            o[2 * e + 1] = bf_hi(bg[e]) * (wh0 * bf_hi(u0[e]) * bf_hi(g0[e]) + wh1 * bf_hi(u1[e]) * bf_hi(g1[e]) + wh2 * bf_hi(u2[e]) * bf_hi(g2[e]));
        }
        u32x4 w; w.x = pk2(o[0], o[1]); w.y = pk2(o[2], o[3]); w.z = pk2(o[4], o[5]); w.w = pk2(o[6], o[7]);
        *(u32x4*)(AC + (size_t)tok * 1024 + 512 + c8) = w;
    }
}

DI void p7_final(const Params& p, int gw, int NGW, int lane) {
    const float* RSQ = (const float*)(p.ws + WS_RSQ2); const float* gf = p.in[13];
    f32x4 gv[4];
#pragma unroll
    for (int j = 0; j < 4; ++j) gv[j] = *((const f32x4*)gf + lane + 64 * j);
    for (int row = gw; row < M; row += NGW) {
        float s = lane < 16 ? RSQ[(size_t)row * 16 + lane] : 0.f;
#pragma unroll
        for (int o = 1; o < 16; o <<= 1) s += __shfl_xor(s, o);
        s = __shfl(s, 0);
        const float rs = 1.0f / sqrtf(s * (1.0f / D) + RMS_EPS);
        f32x4* xr = (f32x4*)(p.out + (size_t)row * D) + lane;
#pragma unroll
        for (int j = 0; j < 4; ++j) xr[64 * j] = xr[64 * j] * rs * gv[j];
    }
}

__global__ void __launch_bounds__(512, 2) fwd_megakernel(Params p) {
    extern __shared__ __attribute__((aligned(16))) unsigned char lds_raw[];
    LAS unsigned char* lds = (LAS unsigned char*)lds_raw;
    cg::grid_group grid = cg::this_grid();
    const int tid = threadIdx.x, lane = tid & 63, wave = __builtin_amdgcn_readfirstlane(tid >> 6);
    const int G = gridDim.x, bx = blockIdx.x;
    const int gw = bx * 8 + wave, NGW = G * 8;
    unsigned char* ws = p.ws;
    const int lo = p.ph_lo, hi = p.ph_hi;
#define IN(k) (lo <= (k) && (k) < hi)
#define SEAM(k) do { if (IN(k) && IN((k) + 1)) grid.sync(); } while (0)
    bf16_t* XN = (bf16_t*)(ws + WS_XN); bf16_t* Wt_in = (bf16_t*)(ws + WS_WIN);

    if (IN(0)) { p0_prologue(p, lds, gw, NGW, wave, lane); }
    SEAM(0);
    if (IN(1)) {
        { pg8::Gemm g{XN, Wt_in, M, NMAIN, D, D}; pg8::StaticOrder S; S.init(M, NMAIN, G, bx);
          EpiProj E{(bf16_t*)(ws + WS_Q), (bf16_t*)(ws + WS_K), (bf16_t*)(ws + WS_UBC), (bf16_t*)(ws + WS_G), p.in[4]};
          pg8::gemm_phase<EpiProj, pg8::StaticOrder, true>(lds, g, S, E); }
        { pg8::Gemm g{Wt_in + (size_t)NMAIN * D, XN, DA, M, D, D}; pg8::StaticOrder S; S.init(DA, M, G, bx);
          EpiVT E{(bf16_t*)(ws + WS_VT)};
          pg8::gemm_phase<EpiVT, pg8::StaticOrder, true>(lds, g, S, E); }
    }
    SEAM(1);
    if (IN(2)) { p2_conv(p, bx * 512 + tid, G * 512); p2_attention(p, lds, tid, wave, lane, G, bx); __syncthreads(); }
    SEAM(2);
    if (IN(3)) {
        { pg8::Gemm g{(bf16_t*)(ws + WS_AC), (bf16_t*)(ws + WS_WA), M, D, DA, D}; pg8::StaticOrder S; S.init(M, D, G, bx);
          EpiBranch E{(bf16_t*)(ws + WS_MG), (const bf16_t*)(ws + WS_G), 0};
          pg8::gemm_phase<EpiBranch, pg8::StaticOrder, true>(lds, g, S, E); }
        { pg8::Gemm g{(bf16_t*)(ws + WS_AC) + DA, (bf16_t*)(ws + WS_WC), M, D, DA, D}; pg8::StaticOrder S; S.init(M, D, G, bx);
          EpiBranch E{(bf16_t*)(ws + WS_MG), (const bf16_t*)(ws + WS_G), 1};
          pg8::gemm_phase<EpiBranch, pg8::StaticOrder, true>(lds, g, S, E); }
    }
    SEAM(3);
    if (IN(4)) {
        pg8::Gemm g{(bf16_t*)(ws + WS_MG), (bf16_t*)(ws + WS_WOUT), M, D, D, D}; pg8::StaticOrder S; S.init(M, D, G, bx);
        EpiResid E{p.in[0], p.in[1], p.out, (bf16_t*)(ws + WS_X1B), (float*)(ws + WS_RSQ1), 0};
        pg8::gemm_phase<EpiResid, pg8::StaticOrder, true>(lds, g, S, E);
    }
    SEAM(4);
    if (IN(5)) {
        pg8::Gemm g{(bf16_t*)(ws + WS_X1B), (bf16_t*)(ws + WS_WFI), M, 2 * DFF, D, D}; pg8::StaticOrder S; S.init(M, 2 * DFF, G, bx);
        EpiFfnIn E{(bf16_t*)(ws + WS_ACT), (const float*)(ws + WS_RSQ1)};
        pg8::gemm_phase<EpiFfnIn, pg8::StaticOrder, true>(lds, g, S, E);
    }
    SEAM(5);
    if (IN(6)) {
        pg8::Gemm g{(bf16_t*)(ws + WS_ACT), (bf16_t*)(ws + WS_WFD), M, D, DFF, DFF}; pg8::StaticOrder S; S.init(M, D, G, bx);
        EpiResid E{nullptr, nullptr, p.out, nullptr, (float*)(ws + WS_RSQ2), 1};
        pg8::gemm_phase<EpiResid, pg8::StaticOrder, true>(lds, g, S, E);
    }
    SEAM(6);
    if (IN(7)) { p7_final(p, gw, NGW, lane); }
#undef IN
#undef SEAM
}

extern "C" void kernel_launch(void* const* d_in, const int* in_sizes, int n_in, void* d_out, int out_size, void* d_ws, size_t ws_size, hipStream_t stream) {
    static int grid_blocks = 0;
    if (grid_blocks == 0) {
        if (n_in != 14 || in_sizes[0] != MP * D || in_sizes[1] != (M - MP) * D || out_size != M * D || ws_size < WS_END) {
            fprintf(stderr, "kernel_launch: unexpected shapes / workspace (n_in %d, ws %zu); nothing launched\n", n_in, ws_size); grid_blocks = -1; return; }
        int dev = 0, cus = 0, per_cu = 0;
        (void)hipGetDevice(&dev);
        (void)hipDeviceGetAttribute(&cus, hipDeviceAttributeMultiprocessorCount, dev);
        (void)hipFuncSetAttribute((const void*)fwd_megakernel, hipFuncAttributeMaxDynamicSharedMemorySize, LDS_BYTES);
        (void)hipOccupancyMaxActiveBlocksPerMultiprocessor(&per_cu, (const void*)fwd_megakernel, 512, LDS_BYTES);
        (void)hipGetLastError();
        if (per_cu < 1) per_cu = 1;
        grid_blocks = cus * per_cu;
    }
    if (grid_blocks < 0) return;
    Params p{};
    for (int i = 0; i < 14; ++i) p.in[i] = (const float*)d_in[i];
    p.out = (float*)d_out; p.ws = (unsigned char*)d_ws; p.ph_lo = 0; p.ph_hi = 8;
    void* args[] = {&p};
    hipError_t e = hipLaunchCooperativeKernel((const void*)fwd_megakernel, dim3(grid_blocks), dim3(512), args, LDS_BYTES, stream);
    if (e != hipSuccess) fprintf(stderr, "cooperative launch failed: %s (grid %d)\n", hipGetErrorString(e), grid_blocks);
}
```

```cpp
#include <hip/hip_runtime.h>
#include <hip/hip_cooperative_groups.h>
#include <cstdio>
#include <cstdint>
namespace cg = cooperative_groups;

#define DI __device__ __forceinline__
#define LAS __attribute__((address_space(3)))
typedef unsigned short bf16_t;
typedef short bf16x8 __attribute__((ext_vector_type(8)));
typedef short s16x4 __attribute__((ext_vector_type(4)));
typedef float f32x4 __attribute__((ext_vector_type(4)));
typedef float f32x2 __attribute__((ext_vector_type(2)));
typedef unsigned u32x4 __attribute__((ext_vector_type(4)));
typedef unsigned u32x2 __attribute__((ext_vector_type(2)));
typedef __bf16 bf16x2n __attribute__((ext_vector_type(2)));

constexpr int M = 81920, MP = 65536, D = 1024, DA = 512, DFF = 2816, SEQ = 8192;
constexpr int NIN = 5120, NMAIN = 4608;
constexpr float RMS_EPS = 1e-6f, LOG2E = 1.4426950408889634f;
constexpr float QSCALE = 0.125f * LOG2E;
constexpr size_t MiB = 1u << 20;
constexpr size_t WS_WIN = 1 * MiB, WS_WA = 11 * MiB, WS_WC = 12 * MiB, WS_WOUT = 13 * MiB, WS_WFI = 15 * MiB, WS_WFD = 26 * MiB;
constexpr size_t WS_RSQ1 = 32 * MiB, WS_RSQ2 = 38 * MiB;
constexpr size_t WS_G = 44 * MiB, WS_Q = 364 * MiB, WS_K = 444 * MiB, WS_VT = 524 * MiB, WS_UBC = 604 * MiB, WS_XN = 844 * MiB;
constexpr size_t WS_AC = WS_XN, WS_MG = WS_Q, WS_X1B = WS_VT, WS_ACT = WS_G, WS_END = 1004 * MiB;
constexpr int LDS_BYTES = 135168;

DI unsigned pk2(float lo, float hi) { f32x2 v = {lo, hi}; return __builtin_bit_cast(unsigned, __builtin_convertvector(v, bf16x2n)); }
DI float bf_lo(unsigned w) { return __uint_as_float(w << 16); }
DI float bf_hi(unsigned w) { return __uint_as_float(w & 0xffff0000u); }
DI float fast_sigmoid(float v) { return __builtin_amdgcn_rcpf(1.0f + __builtin_amdgcn_exp2f(-v * LOG2E)); }

namespace pg8 {
constexpr int BM = 256, BK = 64, HALF = 128, HTB = HALF * BK * 2, STAGE_BYTES = 8 * HTB, NXCD = 8, WGM = 8;
DI int lds_byte(int r, int c) { const int st = (r >> 4) * 2 + (c >> 5), rr = r & 15, cc = c & 31, ob = rr * 64 + cc * 2; return st * 1024 + (ob ^ (((ob >> 9) & 1) << 5)); }
DI void stage_rc(int b, int& R, int& C) { const int st = b / 1024, sb = b % 1024, swz = sb ^ (((sb >> 9) & 1) << 5); R = (st >> 1) * 16 + swz / 64; C = (st & 1) * 32 + (swz % 64) / 2; }
DI int perm32(int rho) { const int n = rho >> 4, i = rho & 15; return 8 * (i >> 2) + 4 * n + (i & 3); }

struct Unit { int pm, pn; };
struct Gemm { const bf16_t* A; const bf16_t* Bt; int M, N, K, lda; };

struct StaticOrder {
    int nM, nN, nwg, G, c;
    DI void init(int M_, int N_, int G_, int c_) { nM = M_ / BM; nN = N_ / BM; nwg = nM * nN; G = G_; c = c_; }
    DI bool next(int i, Unit& u) const {
        const long L = (long)i * G + c; if (L >= nwg) return false;
        int wgid = (int)L; { const int q = nwg / NXCD, r = nwg % NXCD, xcd = wgid % NXCD, off = wgid / NXCD; wgid = (xcd < r ? xcd * (q + 1) : r * (q + 1) + (xcd - r) * q) + off; }
        const int nig = WGM * nN, gid = wgid / nig, fm = gid * WGM, gsz = (nM - fm) < WGM ? (nM - fm) : WGM;
        u.pm = fm + ((wgid % nig) % gsz); u.pn = (wgid % nig) / gsz; return true;
    }
};

template <class Epi, class Sched, bool ALIGN_EPI>
DI void gemm_phase(LAS unsigned char* lds, const Gemm g, const Sched& S, const Epi& E) {
    const int tid = threadIdx.x, wid = __builtin_amdgcn_readfirstlane(tid >> 6), lane = tid & 63, wr = wid >> 2, wc = wid & 3, fr = lane & 15, fq = lane >> 4;
    const int K = g.K, nt = K / BK, lda = g.lda;
    unsigned voffA[2], voffB[2];
#pragma unroll
    for (int i = 0; i < 2; ++i) { int R, C; stage_rc(tid * 16 + i * 8192, R, C); const int Rb = Epi::PERM ? ((R & ~31) + perm32(R & 31)) : R;
        voffA[i] = (unsigned)(R * lda + C) * 2u; voffB[i] = (unsigned)(Rb * K + C) * 2u; }
    const size_t kstep = (size_t)(BK * 2);
    const size_t hstepA = (size_t)HALF * lda * 2, hstepB = (size_t)HALF * K * 2;
    const size_t tstepA = 2 * hstepA, tstepB = 2 * hstepB;
    const unsigned ldsw = (unsigned)wid * 1024u;
    const int aoff = lds_byte(wr * 64 + fr, fq * 8), boff = lds_byte(wc * 32 + fr, fq * 8);
#define PG8_SA(b, h) (((b) * 2 + (h)) * HTB)
#define PG8_SB(b, h) ((4 + (b) * 2 + (h)) * HTB)
#define PG8_STAGE(bufoff, gbase, voff) do { _Pragma("unroll") for (int _i = 0; _i < 2; ++_i) \
        __builtin_amdgcn_global_load_lds((const unsigned*)((const char*)(gbase) + (voff)[_i]), (LAS unsigned*)(lds + (bufoff) + ldsw + _i * 8192), 16, 0, 0); } while (0)
#define PG8_LDA(dst, b, h) do { _Pragma("unroll") for (int m = 0; m < 4; ++m) _Pragma("unroll") for (int k = 0; k < 2; ++k) dst[m][k] = *(const LAS bf16x8*)(lds + PG8_SA(b, h) + aoff + m * 2048 + k * 1024); } while (0)
#define PG8_LDB(dst, b, h) do { _Pragma("unroll") for (int n = 0; n < 2; ++n) _Pragma("unroll") for (int k = 0; k < 2; ++k) dst[n][k] = *(const LAS bf16x8*)(lds + PG8_SB(b, h) + boff + n * 2048 + k * 1024); } while (0)
#define PG8_MMA(ai, bj, At, Bt) do { __builtin_amdgcn_s_setprio(1); _Pragma("unroll") for (int m = 0; m < 4; ++m) _Pragma("unroll") for (int n = 0; n < 2; ++n) _Pragma("unroll") for (int k = 0; k < 2; ++k) \
        acc[ai][bj][m][n] = __builtin_amdgcn_mfma_f32_16x16x32_bf16(Bt[n][k], At[m][k], acc[ai][bj][m][n], 0, 0, 0); __builtin_amdgcn_s_setprio(0); } while (0)
#define PG8_WAIT_V(n) asm volatile("s_waitcnt vmcnt(" #n ")" ::: "memory")
#define PG8_WAIT_L(n) asm volatile("s_waitcnt lgkmcnt(" #n ")" ::: "memory")
#define PG8_BAR __builtin_amdgcn_s_barrier()
#define PG8_SCHED __builtin_amdgcn_sched_barrier(0)
    Unit cur, nxt; int ui = 0;
    if (!S.next(0, cur)) return;
    f32x4 acc[2][2][4][2];
#pragma unroll
    for (int a = 0; a < 2; ++a)
#pragma unroll
        for (int b = 0; b < 2; ++b)
#pragma unroll
            for (int m = 0; m < 4; ++m)
#pragma unroll
                for (int n = 0; n < 2; ++n) acc[a][b][m][n] = (f32x4){0.f, 0.f, 0.f, 0.f};
    bf16x8 At[4][2], B0[2][2], B1[2][2];
    const char* cA = (const char*)g.A + (size_t)cur.pm * tstepA; const char* cB = (const char*)g.Bt + (size_t)cur.pn * tstepB;
    PG8_STAGE(PG8_SB(0, 0), cB, voffB); PG8_STAGE(PG8_SB(0, 1), cB + hstepB, voffB); PG8_STAGE(PG8_SA(0, 0), cA, voffA); PG8_STAGE(PG8_SA(0, 1), cA + hstepA, voffA);
    if (wr == 1) PG8_BAR;
    PG8_WAIT_V(2); PG8_BAR;
    PG8_STAGE(PG8_SB(1, 0), cB + kstep, voffB); PG8_STAGE(PG8_SA(1, 0), cA + kstep, voffA); PG8_STAGE(PG8_SB(1, 1), cB + hstepB + kstep, voffB);
    PG8_WAIT_V(6); PG8_BAR;
    for (;;) {
        const bool has_next = S.next(ui + 1, nxt);
        const char* nA = has_next ? (const char*)g.A + (size_t)nxt.pm * tstepA : cA; const char* nB = has_next ? (const char*)g.Bt + (size_t)nxt.pn * tstepB : cB;
        for (int t = 0; t < nt; t += 2) {
            const bool last = (t == nt - 2);
            const char* a1 = cA + (size_t)(t + 1) * kstep;
            const char* a2 = last ? nA : cA + (size_t)(t + 2) * kstep; const char* b2 = last ? nB : cB + (size_t)(t + 2) * kstep;
            const char* a3 = a2 + kstep; const char* b3 = b2 + kstep;
            PG8_LDB(B0, 0, 0); PG8_LDB(B1, 0, 1); PG8_SCHED; PG8_LDA(At, 0, 0); PG8_STAGE(PG8_SA(1, 1), a1 + hstepA, voffA);
            PG8_WAIT_V(8); PG8_WAIT_L(0); PG8_BAR; PG8_MMA(0, 0, At, B0); PG8_MMA(0, 1, At, B1); PG8_BAR; PG8_SCHED;
            PG8_LDA(At, 0, 1); PG8_STAGE(PG8_SB(0, 0), b2, voffB); PG8_STAGE(PG8_SB(0, 1), b2 + hstepB, voffB); PG8_STAGE(PG8_SA(0, 0), a2, voffA);
            PG8_WAIT_V(8); PG8_WAIT_L(0); PG8_BAR; PG8_MMA(1, 0, At, B0); PG8_MMA(1, 1, At, B1); PG8_BAR; PG8_SCHED;
            PG8_LDB(B0, 1, 0); PG8_LDB(B1, 1, 1); PG8_SCHED; PG8_LDA(At, 1, 0); PG8_STAGE(PG8_SA(0, 1), a2 + hstepA, voffA);
            PG8_WAIT_V(8); PG8_WAIT_L(0); PG8_BAR; PG8_MMA(0, 0, At, B0); PG8_MMA(0, 1, At, B1); PG8_BAR; PG8_SCHED;
            PG8_LDA(At, 1, 1); PG8_STAGE(PG8_SB(1, 0), b3, voffB); PG8_STAGE(PG8_SB(1, 1), b3 + hstepB, voffB); PG8_STAGE(PG8_SA(1, 0), a3, voffA);
            PG8_WAIT_V(8); PG8_WAIT_L(0); PG8_BAR; PG8_MMA(1, 0, At, B0); PG8_MMA(1, 1, At, B1); PG8_BAR; PG8_SCHED;
        }
        if constexpr (ALIGN_EPI) { if (wr == 0) PG8_BAR; }
        E(acc, cur, wr, wc, fr, fq);
        if (!has_next) break;
#pragma unroll
        for (int a = 0; a < 2; ++a)
#pragma unroll
            for (int b = 0; b < 2; ++b)
#pragma unroll
                for (int m = 0; m < 4; ++m)
#pragma unroll
                    for (int n = 0; n < 2; ++n) acc[a][b][m][n] = (f32x4){0.f, 0.f, 0.f, 0.f};
        cur = nxt; cA = nA; cB = nB; ++ui;
        if constexpr (ALIGN_EPI) { if (wr == 1) PG8_BAR; }
    }
    PG8_WAIT_V(0);
    if constexpr (!ALIGN_EPI) { if (wr == 0) PG8_BAR; }
    PG8_BAR;
#undef PG8_SA
#undef PG8_SB
#undef PG8_STAGE
#undef PG8_LDA
#undef PG8_LDB
#undef PG8_MMA
#undef PG8_WAIT_V
#undef PG8_WAIT_L
#undef PG8_BAR
#undef PG8_SCHED
}
}
using pg8::Unit;

struct EpiProj {
    static constexpr bool PERM = true;
    bf16_t *Q, *K, *UBC, *G; const float* bgate;
    DI void operator()(const f32x4 (&acc)[2][2][4][2], const Unit& u, int wr, int wc, int fr, int fq) const {
        const int row0 = u.pm * 256 + wr * 64 + fr, cl = wc * 32 + 8 * fq, pn = u.pn;
        bf16_t* base; int ld; float sc = 1.f; bool gate = false; int gcol = 0;
        if (pn < 2) { base = Q + pn * 256; ld = 512; sc = QSCALE; }
        else if (pn < 4) { base = K + (pn - 2) * 256; ld = 512; }
        else if (pn < 10) { base = UBC + (pn - 4) * 256; ld = 1536; }
        else { base = G + (pn - 10) * 256; ld = 2048; gate = true; gcol = (pn - 10) * 256; }
        f32x4 bv[2][2];
#pragma unroll
        for (int bj = 0; bj < 2; ++bj)
#pragma unroll
            for (int n = 0; n < 2; ++n) bv[bj][n] = gate ? *(const f32x4*)(bgate + gcol + cl + bj * 128 + 4 * n) : (f32x4){0.f, 0.f, 0.f, 0.f};
#pragma unroll
        for (int ai = 0; ai < 2; ++ai)
#pragma unroll
            for (int m = 0; m < 4; ++m) { bf16_t* rowp = base + (size_t)(row0 + ai * 128 + m * 16) * ld + cl;
#pragma unroll
                for (int bj = 0; bj < 2; ++bj) { f32x4 v0 = acc[ai][bj][m][0] + bv[bj][0], v1 = acc[ai][bj][m][1] + bv[bj][1];
                    if (gate) {
#pragma unroll
                        for (int e = 0; e < 4; ++e) { v0[e] = fast_sigmoid(v0[e]); v1[e] = fast_sigmoid(v1[e]); }
                    } else { v0 = v0 * sc; v1 = v1 * sc; }
                    u32x4 w; w.x = pk2(v0[0], v0[1]); w.y = pk2(v0[2], v0[3]); w.z = pk2(v1[0], v1[1]); w.w = pk2(v1[2], v1[3]);
                    *(u32x4*)(rowp + bj * 128) = w; } }
    }
};
struct EpiVT {
    static constexpr bool PERM = true;
    bf16_t* VT;
    DI void operator()(const f32x4 (&acc)[2][2][4][2], const Unit& u, int wr, int wc, int fr, int fq) const {
        const int ch0 = u.pm * 256 + wr * 64 + fr, tokl = u.pn * 256 + wc * 32 + 8 * fq;
#pragma unroll
        for (int ai = 0; ai < 2; ++ai)
#pragma unroll
            for (int m = 0; m < 4; ++m) { const int ch = ch0 + ai * 128 + m * 16, h = ch >> 6, d = ch & 63;
#pragma unroll
                for (int bj = 0; bj < 2; ++bj) { const int tok = tokl + bj * 128, b = tok >> 13, t = tok & 8191, row = t >> 6, col = t & 63;
                    const f32x4 v0 = acc[ai][bj][m][0], v1 = acc[ai][bj][m][1];
                    u32x4 w; w.x = pk2(v0[0], v0[1]); w.y = pk2(v0[2], v0[3]); w.z = pk2(v1[0], v1[1]); w.w = pk2(v1[2], v1[3]);
                    *(u32x4*)(VT + ((((size_t)(b * 8 + h) * 128 + row) * 64 + d) * 64 + col)) = w; } }
    }
};
struct EpiBranch {
    static constexpr bool PERM = true;
    bf16_t* MG; const bf16_t* G; int second;
    DI void operator()(const f32x4 (&acc)[2][2][4][2], const Unit& u, int wr, int wc, int fr, int fq) const {
        const int row0 = u.pm * 256 + wr * 64 + fr, c0 = u.pn * 256 + wc * 32 + 8 * fq;
#pragma unroll
        for (int ai = 0; ai < 2; ++ai) {
            u32x4 gw[4][2], ow[4][2];
#pragma unroll
            for (int m = 0; m < 4; ++m)
#pragma unroll
                for (int bj = 0; bj < 2; ++bj) { const size_t row = (size_t)(row0 + ai * 128 + m * 16); const int c = c0 + bj * 128;
                    gw[m][bj] = *(const u32x4*)(G + row * 2048 + second * 1024 + c);
                    ow[m][bj] = second ? *(const u32x4*)(MG + row * 1024 + c) : (u32x4){0u, 0u, 0u, 0u}; }
#pragma unroll
            for (int m = 0; m < 4; ++m)
#pragma unroll
                for (int bj = 0; bj < 2; ++bj) { const size_t row = (size_t)(row0 + ai * 128 + m * 16); const int c = c0 + bj * 128;
                    const u32x4 g = gw[m][bj], o = ow[m][bj];
                    f32x4 v0 = acc[ai][bj][m][0], v1 = acc[ai][bj][m][1];
                    v0[0] = v0[0] * bf_lo(g.x) + bf_lo(o.x); v0[1] = v0[1] * bf_hi(g.x) + bf_hi(o.x); v0[2] = v0[2] * bf_lo(g.y) + bf_lo(o.y); v0[3] = v0[3] * bf_hi(g.y) + bf_hi(o.y);
                    v1[0] = v1[0] * bf_lo(g.z) + bf_lo(o.z); v1[1] = v1[1] * bf_hi(g.z) + bf_hi(o.z); v1[2] = v1[2] * bf_lo(g.w) + bf_lo(o.w); v1[3] = v1[3] * bf_hi(g.w) + bf_hi(o.w);
                    u32x4 w; w.x = pk2(v0[0], v0[1]); w.y = pk2(v0[2], v0[3]); w.z = pk2(v1[0], v1[1]); w.w = pk2(v1[2], v1[3]);
                    *(u32x4*)(MG + row * 1024 + c) = w; }
        }
    }
};
struct EpiResid {
    static constexpr bool PERM = false;
    const float* xp; const float* xs; float* out; bf16_t* XB; float* RSQ; int inplace;
    DI void operator()(const f32x4 (&acc)[2][2][4][2], const Unit& u, int wr, int wc, int fr, int fq) const {
        const int row0 = u.pm * 256 + wr * 64 + fr, c0 = u.pn * 256 + wc * 32 + 4 * fq;
#pragma unroll
        for (int ai = 0; ai < 2; ++ai) {
            f32x4 xv[4][2][2];
#pragma unroll
            for (int m = 0; m < 4; ++m) { const int row = row0 + ai * 128 + m * 16;
                const float* bp = inplace ? out + (size_t)row * 1024 : (row < MP ? xp + (size_t)row * 1024 : xs + (size_t)(row - MP) * 1024);
#pragma unroll
                for (int bj = 0; bj < 2; ++bj)
#pragma unroll
                    for (int n = 0; n < 2; ++n) xv[m][bj][n] = *(const f32x4*)(bp + c0 + bj * 128 + n * 16); }
#pragma unroll
            for (int m = 0; m < 4; ++m) { const int row = row0 + ai * 128 + m * 16;
                float ss = 0.f;
#pragma unroll
                for (int bj = 0; bj < 2; ++bj)
#pragma unroll
                    for (int n = 0; n < 2; ++n) { const int c = c0 + bj * 128 + n * 16;
                        const f32x4 o = xv[m][bj][n] + acc[ai][bj][m][n];
                        *(f32x4*)(out + (size_t)row * 1024 + c) = o;
                        if (XB) { u32x2 w; w.x = pk2(o[0], o[1]); w.y = pk2(o[2], o[3]); *(u32x2*)(XB + (size_t)row * 1024 + c) = w; }
                        ss += (o[0] * o[0] + o[1] * o[1]) + (o[2] * o[2] + o[3] * o[3]); }
                ss += __shfl_xor(ss, 16); ss += __shfl_xor(ss, 32);
                if (fq == 0) RSQ[(size_t)row * 16 + u.pn * 4 + wc] = ss; }
        }
    }
};
struct EpiFfnIn {
    static constexpr bool PERM = true;
    bf16_t* ACT; const float* RSQ;
    DI void operator()(const f32x4 (&acc)[2][2][4][2], const Unit& u, int wr, int wc, int fr, int fq) const {
        const int row0 = u.pm * 256 + wr * 64 + fr, c0 = u.pn * 128 + wc * 32 + 8 * fq;
        f32x4 pr[2][4];
#pragma unroll
        for (int ai = 0; ai < 2; ++ai)
#pragma unroll
            for (int m = 0; m < 4; ++m) pr[ai][m] = *(const f32x4*)(RSQ + (size_t)(row0 + ai * 128 + m * 16) * 16 + 4 * fq);
#pragma unroll
        for (int ai = 0; ai < 2; ++ai)
#pragma unroll
            for (int m = 0; m < 4; ++m) { const size_t row = (size_t)(row0 + ai * 128 + m * 16);
                const f32x4 q = pr[ai][m];
                float s = (q[0] + q[1]) + (q[2] + q[3]); s += __shfl_xor(s, 16); s += __shfl_xor(s, 32);
                const float rs = 1.0f / sqrtf(s * (1.0f / 1024.0f) + RMS_EPS);
                float o[8];
#pragma unroll
                for (int n = 0; n < 2; ++n)
#pragma unroll
                    for (int e = 0; e < 4; ++e) { const float gt = acc[ai][0][m][n][e] * rs, up = acc[ai][1][m][n][e] * rs; o[4 * n + e] = gt * fast_sigmoid(gt) * up; }
                u32x4 w; w.x = pk2(o[0], o[1]); w.y = pk2(o[2], o[3]); w.z = pk2(o[4], o[5]); w.w = pk2(o[6], o[7]);
                *(u32x4*)(ACT + row * DFF + c0) = w; }
    }
};

DI float wave_sum(float v) {
#pragma unroll
    for (int o = 1; o < 64; o <<= 1) v += __shfl_xor(v, o);
    return v;
}
DI void transpose_item(const float* W, int K, int N, int srccol0, const float* ks, bf16_t* WT, int dstrow0, int kb, LAS float* scr, int lane) {
    const int k0 = 64 * kb;
#pragma unroll 8
    for (int i = 0; i < 32; ++i) { const int kk = 2 * i + (lane >> 5); float v = W[(size_t)(k0 + kk) * N + srccol0 + (lane & 31)]; if (ks) v *= ks[k0 + kk]; scr[kk * 33 + (lane & 31)] = v; }
    asm volatile("s_waitcnt lgkmcnt(0)" ::: "memory");
    const int c = lane & 7;
#pragma unroll
    for (int j = 0; j < 4; ++j) { const int n = (lane >> 3) + 8 * j; const LAS float* s = scr + (8 * c) * 33 + n;
        u32x4 o; o.x = pk2(s[0 * 33], s[1 * 33]); o.y = pk2(s[2 * 33], s[3 * 33]); o.z = pk2(s[4 * 33], s[5 * 33]); o.w = pk2(s[6 * 33], s[7 * 33]);
        *(u32x4*)(WT + (size_t)(dstrow0 + n) * K + k0 + 8 * c) = o; }
    asm volatile("s_waitcnt lgkmcnt(0)" ::: "memory");
}

struct Params { const float* in[14]; float* out; unsigned char* ws; int ph_lo, ph_hi; };

DI void p0_prologue(const Params& p, LAS unsigned char* lds, int gw, int NGW, int wave, int lane) {
    unsigned char* ws = p.ws;
    LAS float* scr = (LAS float*)(lds + wave * 16384);
    const float *w_in = p.in[3], *wa = p.in[7], *wc = p.in[8], *wout = p.in[9], *gffn = p.in[10], *wfi = p.in[11], *wfd = p.in[12];
    constexpr int I_IN = 16 * (NIN / 32), I_A = 8 * 32, I_C = 8 * 32, I_O = 16 * 32, I_FI = 16 * (2 * DFF / 32), I_FD = (DFF / 64) * 32;
    constexpr int NITEMS = I_IN + I_A + I_C + I_O + I_FI + I_FD;
    for (int it = gw; it < NITEMS; it += NGW) {
        int r = it;
        if (r < I_IN) { const int nblk = NIN / 32, kb = r / nblk, n0 = 32 * (r % nblk);
            const int src = n0 < 1024 ? n0 : (n0 < NMAIN ? n0 + 512 : n0 - NMAIN + 1024);
            transpose_item(w_in, D, NIN, src, nullptr, (bf16_t*)(ws + WS_WIN), n0, kb, scr, lane); continue; } r -= I_IN;
        if (r < I_A) { transpose_item(wa, DA, D, 32 * (r % 32), nullptr, (bf16_t*)(ws + WS_WA), 32 * (r % 32), r / 32, scr, lane); continue; } r -= I_A;
        if (r < I_C) { transpose_item(wc, DA, D, 32 * (r % 32), nullptr, (bf16_t*)(ws + WS_WC), 32 * (r % 32), r / 32, scr, lane); continue; } r -= I_C;
        if (r < I_O) { transpose_item(wout, D, D, 32 * (r % 32), nullptr, (bf16_t*)(ws + WS_WOUT), 32 * (r % 32), r / 32, scr, lane); continue; } r -= I_O;
        if (r < I_FI) { const int nblk = 2 * DFF / 32, kb = r / nblk, n0 = 32 * (r % nblk);
            const int pn = n0 >> 8, within = n0 & 255, src = (within >> 7) * DFF + 128 * pn + (within & 127);
            transpose_item(wfi, D, 2 * DFF, src, gffn, (bf16_t*)(ws + WS_WFI), n0, kb, scr, lane); continue; } r -= I_FI;
        transpose_item(wfd, DFF, D, 32 * (r % 32), nullptr, (bf16_t*)(ws + WS_WFD), 32 * (r % 32), r / 32, scr, lane);
    }
    const float* gm = p.in[2];
    bf16_t* XN = (bf16_t*)(ws + WS_XN);
    f32x4 gv[4];
#pragma unroll
    for (int j = 0; j < 4; ++j) gv[j] = *((const f32x4*)gm + lane + 64 * j);
    for (int row = 2 * gw; row < M; row += 2 * NGW) {
        const float* xrow = row < MP ? p.in[0] + (size_t)row * D : p.in[1] + (size_t)(row - MP) * D;
        const f32x4* xr = (const f32x4*)xrow + lane;
        f32x4 v[2][4]; float s0 = 0.f, s1 = 0.f;
#pragma unroll
        for (int j = 0; j < 4; ++j) { v[0][j] = xr[64 * j]; v[1][j] = xr[256 + 64 * j]; }
#pragma unroll
        for (int j = 0; j < 4; ++j) { s0 += (v[0][j][0] * v[0][j][0] + v[0][j][1] * v[0][j][1]) + (v[0][j][2] * v[0][j][2] + v[0][j][3] * v[0][j][3]);
                                      s1 += (v[1][j][0] * v[1][j][0] + v[1][j][1] * v[1][j][1]) + (v[1][j][2] * v[1][j][2] + v[1][j][3] * v[1][j][3]); }
        const float rs0 = 1.0f / sqrtf(wave_sum(s0) * (1.0f / D) + RMS_EPS), rs1 = 1.0f / sqrtf(wave_sum(s1) * (1.0f / D) + RMS_EPS);
        u32x2* o8 = (u32x2*)(XN + (size_t)row * D) + lane;
#pragma unroll
        for (int j = 0; j < 4; ++j) { const f32x4 y0 = v[0][j] * rs0 * gv[j], y1 = v[1][j] * rs1 * gv[j];
            u32x2 w0, w1; w0.x = pk2(y0[0], y0[1]); w0.y = pk2(y0[2], y0[3]); w1.x = pk2(y1[0], y1[1]); w1.y = pk2(y1[2], y1[3]);
            o8[64 * j] = w0; o8[256 + 64 * j] = w1; }
    }
}

constexpr int TAB_PAD = 64;
DI void p2_attention(const Params& p, LAS unsigned char* lds, int tid, int wave, int lane, int G, int bx) {
    unsigned char* ws = p.ws;
    const bf16_t* Q = (const bf16_t*)(ws + WS_Q); const bf16_t* Kb = (const bf16_t*)(ws + WS_K); const bf16_t* VT = (const bf16_t*)(ws + WS_VT);
    bf16_t* AC = (bf16_t*)(ws + WS_AC);
    const float* rpb = p.in[5];
    LAS float* tab = (LAS float*)lds + TAB_PAD;
    for (int i = tid; i < 8 * 15 * 32 + 2 * TAB_PAD; i += 512) { const int k = i - TAB_PAD; float v = 0.f;
        if (k >= 0 && k < 8 * 15 * 32) { const int h = k / 480, rem = k % 480, ri = rem >> 5, ci = rem & 31; if (ci < 31) v = rpb[(h * 15 + ri) * 31 + ci] * LOG2E; }
        ((LAS float*)lds)[i] = v; }
    __syncthreads();
    const int qi = lane & 15, mq = lane >> 4;
    constexpr int NUNITS = 10 * 8 * 16;
    const int per = (NUNITS + G - 1) / G;
    const int j = wave & 3;
    const int kcol0 = j == 0 ? 0 : (j == 1 ? 8 : (j == 2 ? 24 : 32));
    const int qcol = 16 * j + qi;
    int cstart = qcol - 8; cstart = cstart < 0 ? 0 : (cstart > 48 ? 48 : cstart);
    const int t0 = kcol0 + 4 * mq - cstart;
    bool v0[4];
#pragma unroll
    for (int e = 0; e < 4; ++e) v0[e] = (t0 + e >= 0);
    const int cidx0 = kcol0 + 4 * mq - qcol + 15;
    for (int un = bx * per; un < (bx + 1) * per && un < NUNITS; ++un) {
        const int bh = un >> 4, band = un & 15, b = bh >> 3, h = bh & 7;
        for (int it = 0; it < 4; ++it) {
            const int r = band * 8 + it * 2 + (wave >> 2);
            int rs = r - 4; rs = rs < 0 ? 0 : (rs > 120 ? 120 : rs);
            const size_t qtok = (size_t)b * SEQ + r * 64 + qcol;
            bf16x8 qf[2];
#pragma unroll
            for (int ks = 0; ks < 2; ++ks) qf[ks] = *(const bf16x8*)(Q + qtok * 512 + h * 64 + ks * 32 + mq * 8);
            f32x4 s[8][2];
#pragma unroll
            for (int w = 0; w < 8; ++w) {
                const size_t ktok = (size_t)b * SEQ + (rs + w) * 64 + kcol0 + qi;
#pragma unroll
                for (int cb = 0; cb < 2; ++cb) {
                    const bf16_t* kp = Kb + (ktok + 16 * cb) * 512 + h * 64 + mq * 8;
                    const bf16x8 k0 = *(const bf16x8*)kp, k1 = *(const bf16x8*)(kp + 32);
                    f32x4 a = __builtin_amdgcn_mfma_f32_16x16x32_bf16(k0, qf[0], (f32x4){0.f, 0.f, 0.f, 0.f}, 0, 0, 0);
                    s[w][cb] = __builtin_amdgcn_mfma_f32_16x16x32_bf16(k1, qf[1], a, 0, 0, 0);
                }
            }
            const LAS float* tb = tab + h * 480 + (rs - r + 7) * 32 + cidx0;
            float mx = -1e30f;
#pragma unroll
            for (int w = 0; w < 8; ++w)
#pragma unroll
                for (int cb = 0; cb < 2; ++cb)
#pragma unroll
                    for (int e = 0; e < 4; ++e) { const bool ok = cb == 0 ? v0[e] : !v0[e];
                        const float x = ok ? s[w][cb][e] + tb[32 * w + 16 * cb + e] : -1e30f; s[w][cb][e] = x; mx = fmaxf(mx, x); }
            mx = fmaxf(mx, __shfl_xor(mx, 16)); mx = fmaxf(mx, __shfl_xor(mx, 32));
            float sum = 0.f;
#pragma unroll
            for (int w = 0; w < 8; ++w)
#pragma unroll
                for (int cb = 0; cb < 2; ++cb)
#pragma unroll
                    for (int e = 0; e < 4; ++e) { const float pe = __builtin_amdgcn_exp2f(s[w][cb][e] - mx); s[w][cb][e] = pe; sum += pe; }
            sum += __shfl_xor(sum, 16); sum += __shfl_xor(sum, 32);
            const float inv = 1.0f / sum;
            f32x4 o[4];
#pragma unroll
            for (int db = 0; db < 4; ++db) o[db] = (f32x4){0.f, 0.f, 0.f, 0.f};
            const bf16_t* vbase = VT + ((size_t)(b * 8 + h) * 128 + rs) * 4096 + qi * 64 + kcol0 + 4 * mq;
#pragma unroll
            for (int w = 0; w < 8; ++w) {
                u32x4 pw; pw.x = pk2(s[w][0][0], s[w][0][1]); pw.y = pk2(s[w][0][2], s[w][0][3]); pw.z = pk2(s[w][1][0], s[w][1][1]); pw.w = pk2(s[w][1][2], s[w][1][3]);
                const bf16x8 pf = __builtin_bit_cast(bf16x8, pw);
#pragma unroll
                for (int db = 0; db < 4; ++db) {
                    const bf16_t* vp = vbase + (size_t)w * 4096 + db * 16 * 64;
                    const u32x2 lo = *(const u32x2*)vp, hi = *(const u32x2*)(vp + 16);
                    u32x4 vw; vw.x = lo.x; vw.y = lo.y; vw.z = hi.x; vw.w = hi.y;
                    o[db] = __builtin_amdgcn_mfma_f32_16x16x32_bf16(__builtin_bit_cast(bf16x8, vw), pf, o[db], 0, 0, 0);
                }
            }
#pragma unroll
            for (int db = 0; db < 4; ++db) { const f32x4 y = o[db] * inv; u32x2 w; w.x = pk2(y[0], y[1]); w.y = pk2(y[2], y[3]);
                *(u32x2*)(AC + qtok * 1024 + h * 64 + db * 16 + 4 * mq) = w; }
        }
    }
}
DI void p2_conv(const Params& p, int gtid, int nthreads) {
    unsigned char* ws = p.ws;
    const bf16_t* UBC = (const bf16_t*)(ws + WS_UBC); bf16_t* AC = (bf16_t*)(ws + WS_AC);
    const float* cw = p.in[6];
    for (int idx = gtid; idx < M * 64; idx += nthreads) {
        const int tok = idx >> 6, c8 = (idx & 63) * 8, t = tok & (SEQ - 1);
        const bf16_t* rp = UBC + (size_t)tok * 1536 + c8;
        const u32x4 zero = {0u, 0u, 0u, 0u};
        const u32x4 u1 = *(const u32x4*)rp, g1 = *(const u32x4*)(rp + 1024), bg = *(const u32x4*)(rp + 512);
        const u32x4 u0 = t > 0 ? *(const u32x4*)(rp - 1536) : zero, g0 = t > 0 ? *(const u32x4*)(rp - 1536 + 1024) : zero;
        const u32x4 u2 = t < SEQ - 1 ? *(const u32x4*)(rp + 1536) : zero, g2 = t < SEQ - 1 ? *(const u32x4*)(rp + 1536 + 1024) : zero;
        const f32x4 w0a = *(const f32x4*)(cw + c8), w0b = *(const f32x4*)(cw + c8 + 4), w1a = *(const f32x4*)(cw + 512 + c8), w1b = *(const f32x4*)(cw + 512 + c8 + 4),
                    w2a = *(const f32x4*)(cw + 1024 + c8), w2b = *(const f32x4*)(cw + 1024 + c8 + 4);
        float o[8];
#pragma unroll
        for (int e = 0; e < 4; ++e) {
            const float wl0 = e < 2 ? w0a[2 * e] : w0b[2 * e - 4], wh0 = e < 2 ? w0a[2 * e + 1] : w0b[2 * e - 3];
            const float wl1 = e < 2 ? w1a[2 * e] : w1b[2 * e - 4], wh1 = e < 2 ? w1a[2 * e + 1] : w1b[2 * e - 3];
            const float wl2 = e < 2 ? w2a[2 * e] : w2b[2 * e - 4], wh2 = e < 2 ? w2a[2 * e + 1] : w2b[2 * e - 3];
            o[2 * e]     = bf_lo(bg[e]) * (wl0 * bf_lo(u0[e]) * bf_lo(g0[e]) + wl1 * bf_lo(u1[e]) * bf_lo(g1[e]) + wl2 * bf_lo(u2[e]) * bf_lo(g2[e]));
            o[2 * e + 1] = bf_hi(bg[e]) * (wh0 * bf_hi(u0[e]) * bf_hi(g0[e]) + wh1 * bf_hi(u1[e]) * bf_hi(g1[e]) + wh2 * bf_hi(u2[e]) * bf_hi(g2[e]));
        }
        u32x4 w; w.x = pk2(o[0], o[1]); w.y = pk2(o[2], o[3]); w.z = pk2(o[4], o[5]); w.w = pk2(o[6], o[7]);
        *(u32x4*)(AC + (size_t)tok * 1024 + 512 + c8) = w;
    }
}

DI void p7_final(const Params& p, int gw, int NGW, int lane) {
    const float* RSQ = (const float*)(p.ws + WS_RSQ2); const float* gf = p.in[13];
    f32x4 gv[4];
#pragma unroll
    for (int j = 0; j < 4; ++j) gv[j] = *((const f32x4*)gf + lane + 64 * j);
    for (int row = 2 * gw; row < M; row += 2 * NGW) {
        float s = lane < 32 ? RSQ[(size_t)row * 16 + lane] : 0.f;
#pragma unroll
        for (int o = 1; o < 16; o <<= 1) s += __shfl_xor(s, o);
        const float sa = __shfl(s, 0), sb = __shfl(s, 16);
        const float rs0 = 1.0f / sqrtf(sa * (1.0f / D) + RMS_EPS), rs1 = 1.0f / sqrtf(sb * (1.0f / D) + RMS_EPS);
        f32x4* xr = (f32x4*)(p.out + (size_t)row * D) + lane;
        f32x4 v[2][4];
#pragma unroll
        for (int j = 0; j < 4; ++j) { v[0][j] = xr[64 * j]; v[1][j] = xr[256 + 64 * j]; }
#pragma unroll
        for (int j = 0; j < 4; ++j) { xr[64 * j] = v[0][j] * rs0 * gv[j]; xr[256 + 64 * j] = v[1][j] * rs1 * gv[j]; }
    }
}


#define XB_TMO      128
#define XB_XCNT(j)  (256  + 64 * (j))
#define XB_XSUB(j)  (1280 + 64 * (j))
#define XB_XGEN(j)  (2304 + 64 * (j))
#define XB_TOP      3328
#define XB_TOPGEN   3392
#define XCD_BAR_WORDS 3456
#define XB_SPIN_CAP (1u << 18)
DI unsigned xb_ld(unsigned* p)              { return __hip_atomic_load(p, __ATOMIC_RELAXED, __HIP_MEMORY_SCOPE_AGENT); }
DI unsigned xb_add(unsigned* p, unsigned v) { return __hip_atomic_fetch_add(p, v, __ATOMIC_RELAXED, __HIP_MEMORY_SCOPE_AGENT); }
DI unsigned xb_xcc_id() { return (unsigned)__builtin_amdgcn_s_getreg((3 << 11) | 20) & 0xFu; }
#define XB_SPIN(cond, bar) do { unsigned _sp = 0; while (cond) { __builtin_amdgcn_s_sleep(1); \
    if ((++_sp & 255u) == 0u) { if (xb_ld(&(bar)[XB_TMO])) break; if (_sp > XB_SPIN_CAP) { atomicAdd(&(bar)[XB_TMO], 1u); break; } } } } while (0)
struct XcdBarrier { unsigned* bar; unsigned x; volatile LAS unsigned* st; };
DI XcdBarrier xcd_barrier_post(unsigned* bar, volatile LAS unsigned* st) {
    XcdBarrier b; b.bar = bar; b.x = xb_xcc_id(); b.st = st;
    if (threadIdx.x == 0) (void)xb_add(&bar[XB_XCNT(b.x)], 1u);
    return b;
}
DI void xcd_barrier_complete(unsigned* bar, unsigned x, unsigned& nloc, unsigned& nx) {
    const unsigned G = gridDim.x * gridDim.y * gridDim.z;
    unsigned sum, cnt, mine, sp = 0u;
    for (;;) {
        sum = 0u; cnt = 0u; mine = 0u;
#pragma unroll
        for (unsigned j = 0; j < 16; ++j) { const unsigned c = xb_ld(&bar[XB_XCNT(j)]); sum += c; cnt += (c > 0u) ? 1u : 0u; mine = (j == x) ? c : mine; }
        if (sum == G) break;
        __builtin_amdgcn_s_sleep(1);
        if ((++sp & 255u) == 0u) { if (xb_ld(&bar[XB_TMO])) break; if (sp > XB_SPIN_CAP) { atomicAdd(&bar[XB_TMO], 1u); break; } }
    }
    nloc = mine > 0u ? mine : 1u; nx = cnt > 0u ? cnt : 1u;
}
DI void xcd_barrier(const XcdBarrier& b) {
    asm volatile("s_waitcnt vmcnt(0)" ::: "memory");
    __syncthreads();
    if (threadIdx.x == 0) {
        unsigned* bar = b.bar;
        __builtin_amdgcn_s_waitcnt(0);
        unsigned nloc = b.st[0], nx = b.st[1];
        if (nloc == 0u) { xcd_barrier_complete(bar, b.x, nloc, nx); b.st[0] = nloc; b.st[1] = nx; }
        const unsigned old = xb_add(&bar[XB_XSUB(b.x)], 1u);
        const unsigned gen = old / nloc;
        if (old + 1u == (gen + 1u) * nloc) {
            __builtin_amdgcn_fence(__ATOMIC_RELEASE, "agent");
            asm volatile("s_waitcnt vmcnt(0)" ::: "memory");
            const unsigned og = xb_add(&bar[XB_TOP], 1u);
            const unsigned tg = og / nx;
            if (og + 1u == (tg + 1u) * nx) xb_add(&bar[XB_TOPGEN], 1u);
            else XB_SPIN(xb_ld(&bar[XB_TOPGEN]) == tg, bar);
            __builtin_amdgcn_fence(__ATOMIC_ACQUIRE, "agent");
            xb_add(&bar[XB_XGEN(b.x)], 1u);
            asm volatile("s_waitcnt vmcnt(0)" ::: "memory");
        } else {
            XB_SPIN(xb_ld(&bar[XB_XGEN(b.x)]) == gen, bar);
            __builtin_amdgcn_fence(__ATOMIC_ACQUIRE, "agent");
            asm volatile("s_waitcnt vmcnt(0)" ::: "memory");
        }
    }
    __syncthreads();
}

__global__ void __launch_bounds__(512, 2) fwd_megakernel(Params p) {
    extern __shared__ __attribute__((aligned(16))) unsigned char lds_raw[];
    LAS unsigned char* lds = (LAS unsigned char*)lds_raw;
    cg::grid_group grid = cg::this_grid();
    const int tid = threadIdx.x, lane = tid & 63, wave = __builtin_amdgcn_readfirstlane(tid >> 6);
    const int G = gridDim.x, bx = blockIdx.x;
    const int gw = bx * 8 + wave, NGW = G * 8;
    unsigned char* ws = p.ws;
    const int lo = p.ph_lo, hi = p.ph_hi;
#define IN(k) (lo <= (k) && (k) < hi)
#define SEAM(k) do { if (IN(k) && IN((k) + 1)) { if ((k) == 0) grid.sync(); else xcd_barrier(xbar); } } while (0)
    volatile LAS unsigned* misc = (volatile LAS unsigned*)(lds + 131072);
    if (tid < 16) misc[tid] = 0u;
    __syncthreads();
    const XcdBarrier xbar = xcd_barrier_post((unsigned*)ws, misc + 8);
    bf16_t* XN = (bf16_t*)(ws + WS_XN); bf16_t* Wt_in = (bf16_t*)(ws + WS_WIN);

    if (IN(0)) { p0_prologue(p, lds, gw, NGW, wave, lane); }
    SEAM(0);
    if (IN(1)) {
        { pg8::Gemm g{XN, Wt_in, M, NMAIN, D, D}; pg8::StaticOrder S; S.init(M, NMAIN, G, bx);
          EpiProj E{(bf16_t*)(ws + WS_Q), (bf16_t*)(ws + WS_K), (bf16_t*)(ws + WS_UBC), (bf16_t*)(ws + WS_G), p.in[4]};
          pg8::gemm_phase<EpiProj, pg8::StaticOrder, true>(lds, g, S, E); }
        { pg8::Gemm g{Wt_in + (size_t)NMAIN * D, XN, DA, M, D, D}; pg8::StaticOrder S; S.init(DA, M, G, bx);
          EpiVT E{(bf16_t*)(ws + WS_VT)};
          pg8::gemm_phase<EpiVT, pg8::StaticOrder, true>(lds, g, S, E); }
    }
    SEAM(1);
    if (IN(2)) { p2_conv(p, bx * 512 + tid, G * 512); p2_attention(p, lds, tid, wave, lane, G, bx); __syncthreads(); }
    SEAM(2);
    if (IN(3)) {
        { pg8::Gemm g{(bf16_t*)(ws + WS_AC), (bf16_t*)(ws + WS_WA), M, D, DA, D}; pg8::StaticOrder S; S.init(M, D, G, bx);
          EpiBranch E{(bf16_t*)(ws + WS_MG), (const bf16_t*)(ws + WS_G), 0};
          pg8::gemm_phase<EpiBranch, pg8::StaticOrder, true>(lds, g, S, E); }
        { pg8::Gemm g{(bf16_t*)(ws + WS_AC) + DA, (bf16_t*)(ws + WS_WC), M, D, DA, D}; pg8::StaticOrder S; S.init(M, D, G, bx);
          EpiBranch E{(bf16_t*)(ws + WS_MG), (const bf16_t*)(ws + WS_G), 1};
          pg8::gemm_phase<EpiBranch, pg8::StaticOrder, true>(lds, g, S, E); }
    }
    SEAM(3);
    if (IN(4)) {
        pg8::Gemm g{(bf16_t*)(ws + WS_MG), (bf16_t*)(ws + WS_WOUT), M, D, D, D}; pg8::StaticOrder S; S.init(M, D, G, bx);
        EpiResid E{p.in[0], p.in[1], p.out, (bf16_t*)(ws + WS_X1B), (float*)(ws + WS_RSQ1), 0};
        pg8::gemm_phase<EpiResid, pg8::StaticOrder, true>(lds, g, S, E);
    }
    SEAM(4);
    if (IN(5)) {
        pg8::Gemm g{(bf16_t*)(ws + WS_X1B), (bf16_t*)(ws + WS_WFI), M, 2 * DFF, D, D}; pg8::StaticOrder S; S.init(M, 2 * DFF, G, bx);
        EpiFfnIn E{(bf16_t*)(ws + WS_ACT), (const float*)(ws + WS_RSQ1)};
        pg8::gemm_phase<EpiFfnIn, pg8::StaticOrder, true>(lds, g, S, E);
    }
    SEAM(5);
    if (IN(6)) {
        pg8::Gemm g{(bf16_t*)(ws + WS_ACT), (bf16_t*)(ws + WS_WFD), M, D, DFF, DFF}; pg8::StaticOrder S; S.init(M, D, G, bx);
        EpiResid E{nullptr, nullptr, p.out, nullptr, (float*)(ws + WS_RSQ2), 1};
        pg8::gemm_phase<EpiResid, pg8::StaticOrder, true>(lds, g, S, E);
    }
    SEAM(6);
    if (IN(7)) { p7_final(p, gw, NGW, lane); }
#undef IN
#undef SEAM
}

extern "C" void kernel_launch(void* const* d_in, const int* in_sizes, int n_in, void* d_out, int out_size, void* d_ws, size_t ws_size, hipStream_t stream) {
    static int grid_blocks = 0;
    if (grid_blocks == 0) {
        if (n_in != 14 || in_sizes[0] != MP * D || in_sizes[1] != (M - MP) * D || out_size != M * D || ws_size < WS_END) {
            fprintf(stderr, "kernel_launch: unexpected shapes / workspace (n_in %d, ws %zu); nothing launched\n", n_in, ws_size); grid_blocks = -1; return; }
        int dev = 0, cus = 0, per_cu = 0;
        (void)hipGetDevice(&dev);
        (void)hipDeviceGetAttribute(&cus, hipDeviceAttributeMultiprocessorCount, dev);
        (void)hipFuncSetAttribute((const void*)fwd_megakernel, hipFuncAttributeMaxDynamicSharedMemorySize, LDS_BYTES);
        (void)hipOccupancyMaxActiveBlocksPerMultiprocessor(&per_cu, (const void*)fwd_megakernel, 512, LDS_BYTES);
        (void)hipGetLastError();
        if (per_cu < 1) per_cu = 1;
        grid_blocks = cus * per_cu;
    }
    if (grid_blocks < 0) return;
    if (hipMemsetAsync(d_ws, 0, 16384, stream) != hipSuccess) { fprintf(stderr, "kernel_launch: memset of the barrier words failed\n"); return; }
    Params p{};
    for (int i = 0; i < 14; ++i) p.in[i] = (const float*)d_in[i];
    p.out = (float*)d_out; p.ws = (unsigned char*)d_ws; p.ph_lo = 0; p.ph_hi = 8;
    void* args[] = {&p};
    hipError_t e = hipLaunchCooperativeKernel((const void*)fwd_megakernel, dim3(grid_blocks), dim3(512), args, LDS_BYTES, stream);
    if (e != hipSuccess) fprintf(stderr, "cooperative launch failed: %s (grid %d)\n", hipGetErrorString(e), grid_blocks);
}
```

```cpp
#include <hip/hip_runtime.h>
#include <hip/hip_cooperative_groups.h>
#include <cstdio>
#include <cstdint>
namespace cg = cooperative_groups;

#define DI __device__ __forceinline__
#define LAS __attribute__((address_space(3)))
typedef unsigned short bf16_t;
typedef short bf16x8 __attribute__((ext_vector_type(8)));
typedef short s16x4 __attribute__((ext_vector_type(4)));
typedef float f32x4 __attribute__((ext_vector_type(4)));
typedef float f32x2 __attribute__((ext_vector_type(2)));
typedef unsigned u32x4 __attribute__((ext_vector_type(4)));
typedef unsigned u32x2 __attribute__((ext_vector_type(2)));
typedef __bf16 bf16x2n __attribute__((ext_vector_type(2)));

constexpr int M = 81920, MP = 65536, D = 1024, DA = 512, DFF = 2816, SEQ = 8192;
constexpr int NIN = 5120, NMAIN = 4608;
constexpr float RMS_EPS = 1e-6f, LOG2E = 1.4426950408889634f;
constexpr float QSCALE = 0.125f * LOG2E;
constexpr size_t MiB = 1u << 20;
constexpr size_t WS_WIN = 1 * MiB, WS_WA = 11 * MiB, WS_WC = 12 * MiB, WS_WOUT = 13 * MiB, WS_WFI = 15 * MiB, WS_WFD = 26 * MiB;
constexpr size_t WS_RSQ1 = 32 * MiB, WS_RSQ2 = 38 * MiB;
constexpr size_t WS_G = 44 * MiB, WS_Q = 364 * MiB, WS_K = 444 * MiB, WS_VT = 524 * MiB, WS_UBC = 604 * MiB, WS_XN = 844 * MiB;
constexpr size_t WS_AC = WS_XN, WS_MG = WS_Q, WS_X1B = WS_VT, WS_ACT = WS_G, WS_END = 1004 * MiB;
constexpr int LDS_BYTES = 147456, MISC_OFF = 143360;

DI unsigned pk2(float lo, float hi) { f32x2 v = {lo, hi}; return __builtin_bit_cast(unsigned, __builtin_convertvector(v, bf16x2n)); }
DI float bf_lo(unsigned w) { return __uint_as_float(w << 16); }
DI float bf_hi(unsigned w) { return __uint_as_float(w & 0xffff0000u); }
DI float fast_sigmoid(float v) { return __builtin_amdgcn_rcpf(1.0f + __builtin_amdgcn_exp2f(-v * LOG2E)); }

namespace pg8 {
constexpr int BM = 256, BK = 64, HALF = 128, HTB = HALF * BK * 2, STAGE_BYTES = 8 * HTB, NXCD = 8, WGM = 8;
DI int lds_byte(int r, int c) { const int st = (r >> 4) * 2 + (c >> 5), rr = r & 15, cc = c & 31, ob = rr * 64 + cc * 2; return st * 1024 + (ob ^ (((ob >> 9) & 1) << 5)); }
DI void stage_rc(int b, int& R, int& C) { const int st = b / 1024, sb = b % 1024, swz = sb ^ (((sb >> 9) & 1) << 5); R = (st >> 1) * 16 + swz / 64; C = (st & 1) * 32 + (swz % 64) / 2; }
DI int perm32(int rho) { const int n = rho >> 4, i = rho & 15; return 8 * (i >> 2) + 4 * n + (i & 3); }

struct Unit { int pm, pn; };
struct Gemm { const bf16_t* A; const bf16_t* Bt; int M, N, K, lda; };

struct StaticOrder {
    int nM, nN, nwg, G, c;
    DI void init(int M_, int N_, int G_, int c_) { nM = M_ / BM; nN = N_ / BM; nwg = nM * nN; G = G_; c = c_; }
    DI bool next(int i, Unit& u) const {
        const long L = (long)i * G + c; if (L >= nwg) return false;
        int wgid = (int)L; { const int q = nwg / NXCD, r = nwg % NXCD, xcd = wgid % NXCD, off = wgid / NXCD; wgid = (xcd < r ? xcd * (q + 1) : r * (q + 1) + (xcd - r) * q) + off; }
        const int nig = WGM * nN, gid = wgid / nig, fm = gid * WGM, gsz = (nM - fm) < WGM ? (nM - fm) : WGM;
        u.pm = fm + ((wgid % nig) % gsz); u.pn = (wgid % nig) / gsz; return true;
    }
};

template <class Epi, class Sched, bool ALIGN_EPI>
DI void gemm_phase(LAS unsigned char* lds, const Gemm g, const Sched& S, const Epi& E) {
    const int tid = threadIdx.x, wid = __builtin_amdgcn_readfirstlane(tid >> 6), lane = tid & 63, wr = wid >> 2, wc = wid & 3, fr = lane & 15, fq = lane >> 4;
    const int K = g.K, nt = K / BK, lda = g.lda;
    unsigned voffA[2], voffB[2];
#pragma unroll
    for (int i = 0; i < 2; ++i) { int R, C; stage_rc(tid * 16 + i * 8192, R, C); const int Rb = Epi::PERM ? ((R & ~31) + perm32(R & 31)) : R;
        voffA[i] = (unsigned)(R * lda + C) * 2u; voffB[i] = (unsigned)(Rb * K + C) * 2u; }
    const size_t kstep = (size_t)(BK * 2);
    const size_t hstepA = (size_t)HALF * lda * 2, hstepB = (size_t)HALF * K * 2;
    const size_t tstepA = 2 * hstepA, tstepB = 2 * hstepB;
    const unsigned ldsw = (unsigned)wid * 1024u;
    const int aoff = lds_byte(wr * 64 + fr, fq * 8), boff = lds_byte(wc * 32 + fr, fq * 8);
#define PG8_SA(b, h) (((b) * 2 + (h)) * HTB)
#define PG8_SB(b, h) ((4 + (b) * 2 + (h)) * HTB)
#define PG8_STAGE(bufoff, gbase, voff) do { _Pragma("unroll") for (int _i = 0; _i < 2; ++_i) \
        __builtin_amdgcn_global_load_lds((const unsigned*)((const char*)(gbase) + (voff)[_i]), (LAS unsigned*)(lds + (bufoff) + ldsw + _i * 8192), 16, 0, 0); } while (0)
#define PG8_LDA(dst, b, h) do { _Pragma("unroll") for (int m = 0; m < 4; ++m) _Pragma("unroll") for (int k = 0; k < 2; ++k) dst[m][k] = *(const LAS bf16x8*)(lds + PG8_SA(b, h) + aoff + m * 2048 + k * 1024); } while (0)
#define PG8_LDB(dst, b, h) do { _Pragma("unroll") for (int n = 0; n < 2; ++n) _Pragma("unroll") for (int k = 0; k < 2; ++k) dst[n][k] = *(const LAS bf16x8*)(lds + PG8_SB(b, h) + boff + n * 2048 + k * 1024); } while (0)
#define PG8_MMA(ai, bj, At, Bt) do { __builtin_amdgcn_s_setprio(1); _Pragma("unroll") for (int m = 0; m < 4; ++m) _Pragma("unroll") for (int n = 0; n < 2; ++n) _Pragma("unroll") for (int k = 0; k < 2; ++k) \
        acc[ai][bj][m][n] = __builtin_amdgcn_mfma_f32_16x16x32_bf16(Bt[n][k], At[m][k], acc[ai][bj][m][n], 0, 0, 0); __builtin_amdgcn_s_setprio(0); } while (0)
#define PG8_WAIT_V(n) asm volatile("s_waitcnt vmcnt(" #n ")" ::: "memory")
#define PG8_WAIT_L(n) asm volatile("s_waitcnt lgkmcnt(" #n ")" ::: "memory")
#define PG8_BAR __builtin_amdgcn_s_barrier()
#define PG8_SCHED __builtin_amdgcn_sched_barrier(0)
    Unit cur, nxt; int ui = 0;
    if (!S.next(0, cur)) return;
    f32x4 acc[2][2][4][2];
#pragma unroll
    for (int a = 0; a < 2; ++a)
#pragma unroll
        for (int b = 0; b < 2; ++b)
#pragma unroll
            for (int m = 0; m < 4; ++m)
#pragma unroll
                for (int n = 0; n < 2; ++n) acc[a][b][m][n] = (f32x4){0.f, 0.f, 0.f, 0.f};
    bf16x8 At[4][2], B0[2][2], B1[2][2];
    const char* cA = (const char*)g.A + (size_t)cur.pm * tstepA; const char* cB = (const char*)g.Bt + (size_t)cur.pn * tstepB;
    PG8_STAGE(PG8_SB(0, 0), cB, voffB); PG8_STAGE(PG8_SB(0, 1), cB + hstepB, voffB); PG8_STAGE(PG8_SA(0, 0), cA, voffA); PG8_STAGE(PG8_SA(0, 1), cA + hstepA, voffA);
    if (wr == 1) PG8_BAR;
    PG8_WAIT_V(2); PG8_BAR;
    PG8_STAGE(PG8_SB(1, 0), cB + kstep, voffB); PG8_STAGE(PG8_SA(1, 0), cA + kstep, voffA); PG8_STAGE(PG8_SB(1, 1), cB + hstepB + kstep, voffB);
    PG8_WAIT_V(6); PG8_BAR;
    for (;;) {
        const bool has_next = S.next(ui + 1, nxt);
        const char* nA = has_next ? (const char*)g.A + (size_t)nxt.pm * tstepA : cA; const char* nB = has_next ? (const char*)g.Bt + (size_t)nxt.pn * tstepB : cB;
        for (int t = 0; t < nt; t += 2) {
            const bool last = (t == nt - 2);
            const char* a1 = cA + (size_t)(t + 1) * kstep;
            const char* a2 = last ? nA : cA + (size_t)(t + 2) * kstep; const char* b2 = last ? nB : cB + (size_t)(t + 2) * kstep;
            const char* a3 = a2 + kstep; const char* b3 = b2 + kstep;
            PG8_LDB(B0, 0, 0); PG8_LDB(B1, 0, 1); PG8_SCHED; PG8_LDA(At, 0, 0); PG8_STAGE(PG8_SA(1, 1), a1 + hstepA, voffA);
            PG8_WAIT_V(8); PG8_WAIT_L(0); PG8_BAR; PG8_MMA(0, 0, At, B0); PG8_MMA(0, 1, At, B1); PG8_BAR; PG8_SCHED;
            PG8_LDA(At, 0, 1); PG8_STAGE(PG8_SB(0, 0), b2, voffB); PG8_STAGE(PG8_SB(0, 1), b2 + hstepB, voffB); PG8_STAGE(PG8_SA(0, 0), a2, voffA);
            PG8_WAIT_V(8); PG8_WAIT_L(0); PG8_BAR; PG8_MMA(1, 0, At, B0); PG8_MMA(1, 1, At, B1); PG8_BAR; PG8_SCHED;
            PG8_LDB(B0, 1, 0); PG8_LDB(B1, 1, 1); PG8_SCHED; PG8_LDA(At, 1, 0); PG8_STAGE(PG8_SA(0, 1), a2 + hstepA, voffA);
            PG8_WAIT_V(8); PG8_WAIT_L(0); PG8_BAR; PG8_MMA(0, 0, At, B0); PG8_MMA(0, 1, At, B1); PG8_BAR; PG8_SCHED;
            PG8_LDA(At, 1, 1); PG8_STAGE(PG8_SB(1, 0), b3, voffB); PG8_STAGE(PG8_SB(1, 1), b3 + hstepB, voffB); PG8_STAGE(PG8_SA(1, 0), a3, voffA);
            PG8_WAIT_V(8); PG8_WAIT_L(0); PG8_BAR; PG8_MMA(1, 0, At, B0); PG8_MMA(1, 1, At, B1); PG8_BAR; PG8_SCHED;
        }
        if constexpr (ALIGN_EPI) { if (wr == 0) PG8_BAR; }
        E(acc, cur, wr, wc, fr, fq);
        if (!has_next) break;
#pragma unroll
        for (int a = 0; a < 2; ++a)
#pragma unroll
            for (int b = 0; b < 2; ++b)
#pragma unroll
                for (int m = 0; m < 4; ++m)
#pragma unroll
                    for (int n = 0; n < 2; ++n) acc[a][b][m][n] = (f32x4){0.f, 0.f, 0.f, 0.f};
        cur = nxt; cA = nA; cB = nB; ++ui;
        if constexpr (ALIGN_EPI) { if (wr == 1) PG8_BAR; }
    }
    PG8_WAIT_V(0);
    if constexpr (!ALIGN_EPI) { if (wr == 0) PG8_BAR; }
    PG8_BAR;
#undef PG8_SA
#undef PG8_SB
#undef PG8_STAGE
#undef PG8_LDA
#undef PG8_LDB
#undef PG8_MMA
#undef PG8_WAIT_V
#undef PG8_WAIT_L
#undef PG8_BAR
#undef PG8_SCHED
}
}
using pg8::Unit;

struct EpiProj {
    static constexpr bool PERM = true;
    bf16_t *Q, *K, *UBC, *G; const float* bgate;
    DI void operator()(const f32x4 (&acc)[2][2][4][2], const Unit& u, int wr, int wc, int fr, int fq) const {
        const int row0 = u.pm * 256 + wr * 64 + fr, cl = wc * 32 + 8 * fq, pn = u.pn;
        bf16_t* base; int ld; float sc = 1.f; bool gate = false; int gcol = 0;
        if (pn < 2) { base = Q + pn * 256; ld = 512; sc = QSCALE; }
        else if (pn < 4) { base = K + (pn - 2) * 256; ld = 512; }
        else if (pn < 10) { base = UBC + (pn - 4) * 256; ld = 1536; }
        else { base = G + (pn - 10) * 256; ld = 2048; gate = true; gcol = (pn - 10) * 256; }
        f32x4 bv[2][2];
#pragma unroll
        for (int bj = 0; bj < 2; ++bj)
#pragma unroll
            for (int n = 0; n < 2; ++n) bv[bj][n] = gate ? *(const f32x4*)(bgate + gcol + cl + bj * 128 + 4 * n) : (f32x4){0.f, 0.f, 0.f, 0.f};
#pragma unroll
        for (int ai = 0; ai < 2; ++ai)
#pragma unroll
            for (int m = 0; m < 4; ++m) { bf16_t* rowp = base + (size_t)(row0 + ai * 128 + m * 16) * ld + cl;
#pragma unroll
                for (int bj = 0; bj < 2; ++bj) { f32x4 v0 = acc[ai][bj][m][0] + bv[bj][0], v1 = acc[ai][bj][m][1] + bv[bj][1];
                    if (gate) {
#pragma unroll
                        for (int e = 0; e < 4; ++e) { v0[e] = fast_sigmoid(v0[e]); v1[e] = fast_sigmoid(v1[e]); }
                    } else { v0 = v0 * sc; v1 = v1 * sc; }
                    u32x4 w; w.x = pk2(v0[0], v0[1]); w.y = pk2(v0[2], v0[3]); w.z = pk2(v1[0], v1[1]); w.w = pk2(v1[2], v1[3]);
                    *(u32x4*)(rowp + bj * 128) = w; } }
    }
};
struct EpiVT {
    static constexpr bool PERM = true;
    bf16_t* VT;
    DI void operator()(const f32x4 (&acc)[2][2][4][2], const Unit& u, int wr, int wc, int fr, int fq) const {
        const int ch0 = u.pm * 256 + wr * 64 + fr, tokl = u.pn * 256 + wc * 32 + 8 * fq;
#pragma unroll
        for (int ai = 0; ai < 2; ++ai)
#pragma unroll
            for (int m = 0; m < 4; ++m) { const int ch = ch0 + ai * 128 + m * 16, h = ch >> 6, d = ch & 63;
#pragma unroll
                for (int bj = 0; bj < 2; ++bj) { const int tok = tokl + bj * 128, b = tok >> 13, t = tok & 8191, row = t >> 6, col = t & 63;
                    const f32x4 v0 = acc[ai][bj][m][0], v1 = acc[ai][bj][m][1];
                    u32x4 w; w.x = pk2(v0[0], v0[1]); w.y = pk2(v0[2], v0[3]); w.z = pk2(v1[0], v1[1]); w.w = pk2(v1[2], v1[3]);
                    *(u32x4*)(VT + ((((size_t)(b * 8 + h) * 128 + row) * 64 + d) * 64 + col)) = w; } }
    }
};
struct EpiBranch {
    static constexpr bool PERM = true;
    bf16_t* MG; const bf16_t* G; int second;
    DI void operator()(const f32x4 (&acc)[2][2][4][2], const Unit& u, int wr, int wc, int fr, int fq) const {
        const int row0 = u.pm * 256 + wr * 64 + fr, c0 = u.pn * 256 + wc * 32 + 8 * fq;
#pragma unroll
        for (int ai = 0; ai < 2; ++ai) {
            u32x4 gw[4][2], ow[4][2];
#pragma unroll
            for (int m = 0; m < 4; ++m)
#pragma unroll
                for (int bj = 0; bj < 2; ++bj) { const size_t row = (size_t)(row0 + ai * 128 + m * 16); const int c = c0 + bj * 128;
                    gw[m][bj] = *(const u32x4*)(G + row * 2048 + second * 1024 + c);
                    ow[m][bj] = second ? *(const u32x4*)(MG + row * 1024 + c) : (u32x4){0u, 0u, 0u, 0u}; }
#pragma unroll
            for (int m = 0; m < 4; ++m)
#pragma unroll
                for (int bj = 0; bj < 2; ++bj) { const size_t row = (size_t)(row0 + ai * 128 + m * 16); const int c = c0 + bj * 128;
                    const u32x4 g = gw[m][bj], o = ow[m][bj];
                    f32x4 v0 = acc[ai][bj][m][0], v1 = acc[ai][bj][m][1];
                    v0[0] = v0[0] * bf_lo(g.x) + bf_lo(o.x); v0[1] = v0[1] * bf_hi(g.x) + bf_hi(o.x); v0[2] = v0[2] * bf_lo(g.y) + bf_lo(o.y); v0[3] = v0[3] * bf_hi(g.y) + bf_hi(o.y);
                    v1[0] = v1[0] * bf_lo(g.z) + bf_lo(o.z); v1[1] = v1[1] * bf_hi(g.z) + bf_hi(o.z); v1[2] = v1[2] * bf_lo(g.w) + bf_lo(o.w); v1[3] = v1[3] * bf_hi(g.w) + bf_hi(o.w);
                    u32x4 w; w.x = pk2(v0[0], v0[1]); w.y = pk2(v0[2], v0[3]); w.z = pk2(v1[0], v1[1]); w.w = pk2(v1[2], v1[3]);
                    *(u32x4*)(MG + row * 1024 + c) = w; }
        }
    }
};
struct EpiResid {
    static constexpr bool PERM = false;
    const float* xp; const float* xs; float* out; bf16_t* XB; float* RSQ; int inplace;
    DI void operator()(const f32x4 (&acc)[2][2][4][2], const Unit& u, int wr, int wc, int fr, int fq) const {
        const int row0 = u.pm * 256 + wr * 64 + fr, c0 = u.pn * 256 + wc * 32 + 4 * fq;
#pragma unroll
        for (int ai = 0; ai < 2; ++ai) {
            f32x4 xv[4][2][2];
#pragma unroll
            for (int m = 0; m < 4; ++m) { const int row = row0 + ai * 128 + m * 16;
                const float* bp = inplace ? out + (size_t)row * 1024 : (row < MP ? xp + (size_t)row * 1024 : xs + (size_t)(row - MP) * 1024);
#pragma unroll
                for (int bj = 0; bj < 2; ++bj)
#pragma unroll
                    for (int n = 0; n < 2; ++n) xv[m][bj][n] = *(const f32x4*)(bp + c0 + bj * 128 + n * 16); }
#pragma unroll
            for (int m = 0; m < 4; ++m) { const int row = row0 + ai * 128 + m * 16;
                float ss = 0.f;
#pragma unroll
                for (int bj = 0; bj < 2; ++bj)
#pragma unroll
                    for (int n = 0; n < 2; ++n) { const int c = c0 + bj * 128 + n * 16;
                        const f32x4 o = xv[m][bj][n] + acc[ai][bj][m][n];
                        *(f32x4*)(out + (size_t)row * 1024 + c) = o;
                        if (XB) { u32x2 w; w.x = pk2(o[0], o[1]); w.y = pk2(o[2], o[3]); *(u32x2*)(XB + (size_t)row * 1024 + c) = w; }
                        ss += (o[0] * o[0] + o[1] * o[1]) + (o[2] * o[2] + o[3] * o[3]); }
                ss += __shfl_xor(ss, 16); ss += __shfl_xor(ss, 32);
                if (fq == 0) RSQ[(size_t)row * 16 + u.pn * 4 + wc] = ss; }
        }
    }
};
struct EpiFfnIn {
    static constexpr bool PERM = true;
    bf16_t* ACT; const float* RSQ;
    DI void operator()(const f32x4 (&acc)[2][2][4][2], const Unit& u, int wr, int wc, int fr, int fq) const {
        const int row0 = u.pm * 256 + wr * 64 + fr, c0 = u.pn * 128 + wc * 32 + 8 * fq;
        f32x4 pr[2][4];
#pragma unroll
        for (int ai = 0; ai < 2; ++ai)
#pragma unroll
            for (int m = 0; m < 4; ++m) pr[ai][m] = *(const f32x4*)(RSQ + (size_t)(row0 + ai * 128 + m * 16) * 16 + 4 * fq);
#pragma unroll
        for (int ai = 0; ai < 2; ++ai)
#pragma unroll
            for (int m = 0; m < 4; ++m) { const size_t row = (size_t)(row0 + ai * 128 + m * 16);
                const f32x4 q = pr[ai][m];
                float s = (q[0] + q[1]) + (q[2] + q[3]); s += __shfl_xor(s, 16); s += __shfl_xor(s, 32);
                const float rs = 1.0f / sqrtf(s * (1.0f / 1024.0f) + RMS_EPS);
                float o[8];
#pragma unroll
                for (int n = 0; n < 2; ++n)
#pragma unroll
                    for (int e = 0; e < 4; ++e) { const float gt = acc[ai][0][m][n][e] * rs, up = acc[ai][1][m][n][e] * rs; o[4 * n + e] = gt * fast_sigmoid(gt) * up; }
                u32x4 w; w.x = pk2(o[0], o[1]); w.y = pk2(o[2], o[3]); w.z = pk2(o[4], o[5]); w.w = pk2(o[6], o[7]);
                *(u32x4*)(ACT + row * DFF + c0) = w; }
    }
};

DI float wave_sum(float v) {
#pragma unroll
    for (int o = 1; o < 64; o <<= 1) v += __shfl_xor(v, o);
    return v;
}
DI void transpose_item(const float* W, int K, int N, int srccol0, const float* ks, bf16_t* WT, int dstrow0, int kb, LAS float* scr, int lane) {
    const int k0 = 64 * kb;
#pragma unroll 8
    for (int i = 0; i < 32; ++i) { const int kk = 2 * i + (lane >> 5); float v = W[(size_t)(k0 + kk) * N + srccol0 + (lane & 31)]; if (ks) v *= ks[k0 + kk]; scr[kk * 33 + (lane & 31)] = v; }
    asm volatile("s_waitcnt lgkmcnt(0)" ::: "memory");
    const int c = lane & 7;
#pragma unroll
    for (int j = 0; j < 4; ++j) { const int n = (lane >> 3) + 8 * j; const LAS float* s = scr + (8 * c) * 33 + n;
        u32x4 o; o.x = pk2(s[0 * 33], s[1 * 33]); o.y = pk2(s[2 * 33], s[3 * 33]); o.z = pk2(s[4 * 33], s[5 * 33]); o.w = pk2(s[6 * 33], s[7 * 33]);
        *(u32x4*)(WT + (size_t)(dstrow0 + n) * K + k0 + 8 * c) = o; }
    asm volatile("s_waitcnt lgkmcnt(0)" ::: "memory");
}

struct Params { const float* in[14]; float* out; unsigned char* ws; int ph_lo, ph_hi; };

DI void p0_prologue(const Params& p, LAS unsigned char* lds, int gw, int NGW, int wave, int lane) {
    unsigned char* ws = p.ws;
    LAS float* scr = (LAS float*)(lds + wave * 16384);
    const float *w_in = p.in[3], *wa = p.in[7], *wc = p.in[8], *wout = p.in[9], *gffn = p.in[10], *wfi = p.in[11], *wfd = p.in[12];
    constexpr int I_IN = 16 * (NIN / 32), I_A = 8 * 32, I_C = 8 * 32, I_O = 16 * 32, I_FI = 16 * (2 * DFF / 32), I_FD = (DFF / 64) * 32;
    constexpr int NITEMS = I_IN + I_A + I_C + I_O + I_FI + I_FD;
    for (int it = gw; it < NITEMS; it += NGW) {
        int r = it;
        if (r < I_IN) { const int nblk = NIN / 32, kb = r / nblk, n0 = 32 * (r % nblk);
            const int src = n0 < 1024 ? n0 : (n0 < NMAIN ? n0 + 512 : n0 - NMAIN + 1024);
            transpose_item(w_in, D, NIN, src, nullptr, (bf16_t*)(ws + WS_WIN), n0, kb, scr, lane); continue; } r -= I_IN;
        if (r < I_A) { transpose_item(wa, DA, D, 32 * (r % 32), nullptr, (bf16_t*)(ws + WS_WA), 32 * (r % 32), r / 32, scr, lane); continue; } r -= I_A;
        if (r < I_C) { transpose_item(wc, DA, D, 32 * (r % 32), nullptr, (bf16_t*)(ws + WS_WC), 32 * (r % 32), r / 32, scr, lane); continue; } r -= I_C;
        if (r < I_O) { transpose_item(wout, D, D, 32 * (r % 32), nullptr, (bf16_t*)(ws + WS_WOUT), 32 * (r % 32), r / 32, scr, lane); continue; } r -= I_O;
        if (r < I_FI) { const int nblk = 2 * DFF / 32, kb = r / nblk, n0 = 32 * (r % nblk);
            const int pn = n0 >> 8, within = n0 & 255, src = (within >> 7) * DFF + 128 * pn + (within & 127);
            transpose_item(wfi, D, 2 * DFF, src, gffn, (bf16_t*)(ws + WS_WFI), n0, kb, scr, lane); continue; } r -= I_FI;
        transpose_item(wfd, DFF, D, 32 * (r % 32), nullptr, (bf16_t*)(ws + WS_WFD), 32 * (r % 32), r / 32, scr, lane);
    }
    const float* gm = p.in[2];
    bf16_t* XN = (bf16_t*)(ws + WS_XN);
    f32x4 gv[4];
#pragma unroll
    for (int j = 0; j < 4; ++j) gv[j] = *((const f32x4*)gm + lane + 64 * j);
    for (int row = 2 * gw; row < M; row += 2 * NGW) {
        const float* xrow = row < MP ? p.in[0] + (size_t)row * D : p.in[1] + (size_t)(row - MP) * D;
        const f32x4* xr = (const f32x4*)xrow + lane;
        f32x4 v[2][4]; float s0 = 0.f, s1 = 0.f;
#pragma unroll
        for (int j = 0; j < 4; ++j) { v[0][j] = xr[64 * j]; v[1][j] = xr[256 + 64 * j]; }
#pragma unroll
        for (int j = 0; j < 4; ++j) { s0 += (v[0][j][0] * v[0][j][0] + v[0][j][1] * v[0][j][1]) + (v[0][j][2] * v[0][j][2] + v[0][j][3] * v[0][j][3]);
                                      s1 += (v[1][j][0] * v[1][j][0] + v[1][j][1] * v[1][j][1]) + (v[1][j][2] * v[1][j][2] + v[1][j][3] * v[1][j][3]); }
        const float rs0 = 1.0f / sqrtf(wave_sum(s0) * (1.0f / D) + RMS_EPS), rs1 = 1.0f / sqrtf(wave_sum(s1) * (1.0f / D) + RMS_EPS);
        u32x2* o8 = (u32x2*)(XN + (size_t)row * D) + lane;
#pragma unroll
        for (int j = 0; j < 4; ++j) { const f32x4 y0 = v[0][j] * rs0 * gv[j], y1 = v[1][j] * rs1 * gv[j];
            u32x2 w0, w1; w0.x = pk2(y0[0], y0[1]); w0.y = pk2(y0[2], y0[3]); w1.x = pk2(y1[0], y1[1]); w1.y = pk2(y1[2], y1[3]);
            o8[64 * j] = w0; o8[256 + 64 * j] = w1; }
    }
}

constexpr int TAB_PAD = 64;
constexpr int AT_RING_OFF = 16384, AT_SLOT_K = 40 * 144, AT_SLOT_V = 64 * 80, AT_SLOT = AT_SLOT_K + AT_SLOT_V, AT_NSLOT = 11;
static_assert(AT_RING_OFF + AT_NSLOT * AT_SLOT <= 139264, "attention ring fits below the LDS control words");
struct AtStage { const bf16_t* Kb; const bf16_t* VT; int b, h, cbase; };
DI void at_chunk(const AtStage& st, int c, int a, const bf16_t*& g, unsigned& l) {
    const int rowi = c / 640, cc = c - rowi * 640, row = a + rowi, slot = row % AT_NSLOT;
    if (cc < 320) { const int col = cc >> 3, part = cc & 7;
        g = st.Kb + ((size_t)st.b * SEQ + row * 64 + st.cbase + col) * 512 + st.h * 64 + part * 8; l = AT_RING_OFF + slot * AT_SLOT + col * 144 + part * 16; }
    else { const int c2 = cc - 320, d = c2 / 5, part = c2 - d * 5;
        g = st.VT + ((size_t)(st.b * 8 + st.h) * 128 + row) * 4096 + d * 64 + st.cbase + part * 8; l = AT_RING_OFF + slot * AT_SLOT + AT_SLOT_K + d * 80 + part * 16; }
}
template <int NB> DI void at_issue(const AtStage& st, int tid, int a, int n, u32x4 (&buf)[NB]) {
    const int total = n * 640;
#pragma unroll
    for (int k = 0; k < NB; ++k) { const int c = tid + k * 512; if (c < total) { const bf16_t* g; unsigned l; at_chunk(st, c, a, g, l); buf[k] = *(const u32x4*)g; } }
}
template <int NB> DI void at_write(const AtStage& st, LAS unsigned char* lds, int tid, int a, int n, const u32x4 (&buf)[NB]) {
    const int total = n * 640;
#pragma unroll
    for (int k = 0; k < NB; ++k) { const int c = tid + k * 512; if (c < total) { const bf16_t* g; unsigned l; at_chunk(st, c, a, g, l); *(LAS u32x4*)(lds + l) = buf[k]; } }
}
DI int clamp_i(int v, int lo, int hi) { return v < lo ? lo : (v > hi ? hi : v); }
DI void p2_attention(const Params& p, LAS unsigned char* lds, int tid, int wave, int lane, int G, int bx) {
    unsigned char* ws = p.ws;
    const bf16_t* Q = (const bf16_t*)(ws + WS_Q);
    bf16_t* AC = (bf16_t*)(ws + WS_AC);
    const float* rpb = p.in[5];
    LAS float* tab = (LAS float*)lds + TAB_PAD;
    for (int i = tid; i < 8 * 15 * 32 + 2 * TAB_PAD; i += 512) { const int k = i - TAB_PAD; float v = 0.f;
        if (k >= 0 && k < 8 * 15 * 32) { const int h = k / 480, rem = k % 480, ri = rem >> 5, ci = rem & 31; if (ci < 31) v = rpb[(h * 15 + ri) * 31 + ci] * LOG2E; }
        ((LAS float*)lds)[i] = v; }
    __syncthreads();
    const int qi = lane & 15, mq = lane >> 4, jj = wave & 1, rr = wave >> 1;
    constexpr int NUNITS = 10 * 8 * 2 * 8;
    const int per = (NUNITS + G - 1) / G;
    for (int un = bx * per; un < (bx + 1) * per && un < NUNITS; ++un) {
        const int band = un & 7, ch = (un >> 3) & 1, bh = un >> 4, b = bh >> 3, h = bh & 7;
        const int j = 2 * ch + jj, cbase = ch ? 24 : 0, kcol0 = cbase + 8 * jj, qcol = 16 * j + qi;
        const int cstart = clamp_i(qcol - 8, 0, 48), t0 = kcol0 + 4 * mq - cstart, cidx0 = kcol0 + 4 * mq - qcol + 15;
        bool v0[4];
#pragma unroll
        for (int e = 0; e < 4; ++e) v0[e] = (t0 + e >= 0);
        AtStage st{(const bf16_t*)(ws + WS_K), (const bf16_t*)(ws + WS_VT), b, h, cbase};
        const int r0 = band * 16;
        int hi = clamp_i(r0 - 1, 0, 120) + 7;
        bf16x8 qf[2];
        { const int lo = clamp_i(r0 - 4, 0, 120);
          for (int a = lo; a <= hi; a += 4) { const int n = hi - a + 1 < 4 ? hi - a + 1 : 4;
              u32x4 buf[5]; at_issue<5>(st, tid, a, n, buf); at_write<5>(st, lds, tid, a, n, buf); }
          const size_t qtok = (size_t)b * SEQ + (r0 + rr) * 64 + qcol;
#pragma unroll
          for (int ks = 0; ks < 2; ++ks) qf[ks] = *(const bf16x8*)(Q + qtok * 512 + h * 64 + ks * 32 + mq * 8); }
        __syncthreads();
        for (int it = 0; it < 4; ++it) {
            const int r = r0 + 4 * it, q = r + rr;
            u32x4 pf[5]; bf16x8 qn[2]; int nhi = hi;
            if (it < 3) { nhi = clamp_i(r + 3, 0, 120) + 7;
                at_issue<5>(st, tid, hi + 1, nhi - hi, pf);
                const size_t qtn = (size_t)b * SEQ + (q + 4) * 64 + qcol;
#pragma unroll
                for (int ks = 0; ks < 2; ++ks) qn[ks] = *(const bf16x8*)(Q + qtn * 512 + h * 64 + ks * 32 + mq * 8); }
            __builtin_amdgcn_sched_barrier(0);
            const int rs = clamp_i(q - 4, 0, 120);
            const size_t qtok = (size_t)b * SEQ + q * 64 + qcol;
            f32x4 s[8][2];
            { int slot = rs % AT_NSLOT;
#pragma unroll
              for (int w = 0; w < 8; ++w) {
                const LAS unsigned char* kb = lds + AT_RING_OFF + slot * AT_SLOT + (8 * jj + qi) * 144 + mq * 16;
#pragma unroll
                for (int cb = 0; cb < 2; ++cb) {
                    const bf16x8 k0 = *(const LAS bf16x8*)(kb + cb * 16 * 144), k1 = *(const LAS bf16x8*)(kb + cb * 16 * 144 + 64);
                    f32x4 a = __builtin_amdgcn_mfma_f32_16x16x32_bf16(k0, qf[0], (f32x4){0.f, 0.f, 0.f, 0.f}, 0, 0, 0);
                    s[w][cb] = __builtin_amdgcn_mfma_f32_16x16x32_bf16(k1, qf[1], a, 0, 0, 0);
                }
                slot = slot + 1 == AT_NSLOT ? 0 : slot + 1;
              } }
            const LAS float* tb = tab + h * 480 + (rs - q + 7) * 32 + cidx0;
            float mx = -1e30f;
#pragma unroll
            for (int w = 0; w < 8; ++w)
#pragma unroll
                for (int cb = 0; cb < 2; ++cb)
#pragma unroll
                    for (int e = 0; e < 4; ++e) { const bool ok = cb == 0 ? v0[e] : !v0[e];
                        const float x = ok ? s[w][cb][e] + tb[32 * w + 16 * cb + e] : -1e30f; s[w][cb][e] = x; mx = fmaxf(mx, x); }
            mx = fmaxf(mx, __shfl_xor(mx, 16)); mx = fmaxf(mx, __shfl_xor(mx, 32));
            float sum = 0.f;
#pragma unroll
            for (int w = 0; w < 8; ++w)
#pragma unroll
                for (int cb = 0; cb < 2; ++cb)
#pragma unroll
                    for (int e = 0; e < 4; ++e) { const float pe = __builtin_amdgcn_exp2f(s[w][cb][e] - mx); s[w][cb][e] = pe; sum += pe; }
            sum += __shfl_xor(sum, 16); sum += __shfl_xor(sum, 32);
            const float inv = 1.0f / sum;
            f32x4 o[4];
#pragma unroll
            for (int db = 0; db < 4; ++db) o[db] = (f32x4){0.f, 0.f, 0.f, 0.f};
            { int slot = rs % AT_NSLOT;
#pragma unroll
              for (int w = 0; w < 8; ++w) {
                u32x4 pw; pw.x = pk2(s[w][0][0], s[w][0][1]); pw.y = pk2(s[w][0][2], s[w][0][3]); pw.z = pk2(s[w][1][0], s[w][1][1]); pw.w = pk2(s[w][1][2], s[w][1][3]);
                const bf16x8 pfr = __builtin_bit_cast(bf16x8, pw);
                const LAS unsigned char* vb = lds + AT_RING_OFF + slot * AT_SLOT + AT_SLOT_K + qi * 80 + (8 * jj + 4 * mq) * 2;
#pragma unroll
                for (int db = 0; db < 4; ++db) {
                    const u32x2 lo2 = *(const LAS u32x2*)(vb + db * 16 * 80), hi2 = *(const LAS u32x2*)(vb + db * 16 * 80 + 32);
                    u32x4 vw; vw.x = lo2.x; vw.y = lo2.y; vw.z = hi2.x; vw.w = hi2.y;
                    o[db] = __builtin_amdgcn_mfma_f32_16x16x32_bf16(__builtin_bit_cast(bf16x8, vw), pfr, o[db], 0, 0, 0);
                }
                slot = slot + 1 == AT_NSLOT ? 0 : slot + 1;
              } }
#pragma unroll
            for (int db = 0; db < 4; ++db) { const f32x4 y = o[db] * inv; u32x2 w2; w2.x = pk2(y[0], y[1]); w2.y = pk2(y[2], y[3]);
                *(u32x2*)(AC + qtok * 1024 + h * 64 + db * 16 + 4 * mq) = w2; }
            __syncthreads();
            if (it < 3) { at_write<5>(st, lds, tid, hi + 1, nhi - hi, pf); hi = nhi; qf[0] = qn[0]; qf[1] = qn[1]; }
            __syncthreads();
        }
    }
}
DI void p2_conv(const Params& p, int gtid, int nthreads) {
    unsigned char* ws = p.ws;
    const bf16_t* UBC = (const bf16_t*)(ws + WS_UBC); bf16_t* AC = (bf16_t*)(ws + WS_AC);
    const float* cw = p.in[6];
    const int c8 = (gtid & 63) * 8;
    float wt[3][8];
#pragma unroll
    for (int k = 0; k < 3; ++k) { const f32x4 a = *(const f32x4*)(cw + k * 512 + c8), b = *(const f32x4*)(cw + k * 512 + c8 + 4);
#pragma unroll
        for (int e = 0; e < 4; ++e) { wt[k][e] = a[e]; wt[k][4 + e] = b[e]; } }
    for (int idx = gtid; idx < (M / 4) * 64; idx += nthreads) {
        const int run = idx >> 6, tok0 = run * 4, t = tok0 & (SEQ - 1);
        const bf16_t* rp = UBC + (size_t)tok0 * 1536 + c8;
        const u32x4 zero = {0u, 0u, 0u, 0u};
        u32x4 uu[6], gg[6], bg[4];
#pragma unroll
        for (int i = 0; i < 6; ++i) { const bool ok = !((i == 0 && t == 0) || (i == 5 && t == SEQ - 4));
            uu[i] = ok ? *(const u32x4*)(rp + (ptrdiff_t)(i - 1) * 1536) : zero; gg[i] = ok ? *(const u32x4*)(rp + (ptrdiff_t)(i - 1) * 1536 + 1024) : zero; }
#pragma unroll
        for (int i = 0; i < 4; ++i) bg[i] = *(const u32x4*)(rp + (size_t)i * 1536 + 512);
        float z[6][8];
#pragma unroll
        for (int i = 0; i < 6; ++i)
#pragma unroll
            for (int e = 0; e < 4; ++e) { z[i][2 * e] = bf_lo(uu[i][e]) * bf_lo(gg[i][e]); z[i][2 * e + 1] = bf_hi(uu[i][e]) * bf_hi(gg[i][e]); }
#pragma unroll
        for (int i = 0; i < 4; ++i) { float o[8];
#pragma unroll
            for (int e = 0; e < 4; ++e) {
                o[2 * e]     = bf_lo(bg[i][e]) * (wt[0][2 * e] * z[i][2 * e] + wt[1][2 * e] * z[i + 1][2 * e] + wt[2][2 * e] * z[i + 2][2 * e]);
                o[2 * e + 1] = bf_hi(bg[i][e]) * (wt[0][2 * e + 1] * z[i][2 * e + 1] + wt[1][2 * e + 1] * z[i + 1][2 * e + 1] + wt[2][2 * e + 1] * z[i + 2][2 * e + 1]); }
            u32x4 w; w.x = pk2(o[0], o[1]); w.y = pk2(o[2], o[3]); w.z = pk2(o[4], o[5]); w.w = pk2(o[6], o[7]);
            *(u32x4*)(AC + (size_t)(tok0 + i) * 1024 + 512 + c8) = w; }
    }
}

DI void p7_final(const Params& p, int gw, int NGW, int lane) {
    const float* RSQ = (const float*)(p.ws + WS_RSQ2); const float* gf = p.in[13];
    f32x4 gv[4];
#pragma unroll
    for (int j = 0; j < 4; ++j) gv[j] = *((const f32x4*)gf + lane + 64 * j);
    for (int row = 2 * gw; row < M; row += 2 * NGW) {
        float s = lane < 32 ? RSQ[(size_t)row * 16 + lane] : 0.f;
#pragma unroll
        for (int o = 1; o < 16; o <<= 1) s += __shfl_xor(s, o);
        const float sa = __shfl(s, 0), sb = __shfl(s, 16);
        const float rs0 = 1.0f / sqrtf(sa * (1.0f / D) + RMS_EPS), rs1 = 1.0f / sqrtf(sb * (1.0f / D) + RMS_EPS);
        f32x4* xr = (f32x4*)(p.out + (size_t)row * D) + lane;
        f32x4 v[2][4];
#pragma unroll
        for (int j = 0; j < 4; ++j) { v[0][j] = xr[64 * j]; v[1][j] = xr[256 + 64 * j]; }
#pragma unroll
        for (int j = 0; j < 4; ++j) { xr[64 * j] = v[0][j] * rs0 * gv[j]; xr[256 + 64 * j] = v[1][j] * rs1 * gv[j]; }
    }
}


#define XB_TMO      128
#define XB_XCNT(j)  (256  + 64 * (j))
#define XB_XSUB(j)  (1280 + 64 * (j))
#define XB_XGEN(j)  (2304 + 64 * (j))
#define XB_TOP      3328
#define XB_TOPGEN   3392
#define XCD_BAR_WORDS 3456
#define XB_SPIN_CAP (1u << 18)
DI unsigned xb_ld(unsigned* p)              { return __hip_atomic_load(p, __ATOMIC_RELAXED, __HIP_MEMORY_SCOPE_AGENT); }
DI unsigned xb_add(unsigned* p, unsigned v) { return __hip_atomic_fetch_add(p, v, __ATOMIC_RELAXED, __HIP_MEMORY_SCOPE_AGENT); }
DI unsigned xb_xcc_id() { return (unsigned)__builtin_amdgcn_s_getreg((3 << 11) | 20) & 0xFu; }
#define XB_SPIN(cond, bar) do { unsigned _sp = 0; while (cond) { __builtin_amdgcn_s_sleep(1); \
    if ((++_sp & 255u) == 0u) { if (xb_ld(&(bar)[XB_TMO])) break; if (_sp > XB_SPIN_CAP) { atomicAdd(&(bar)[XB_TMO], 1u); break; } } } } while (0)
struct XcdBarrier { unsigned* bar; unsigned x; volatile LAS unsigned* st; };
DI XcdBarrier xcd_barrier_post(unsigned* bar, volatile LAS unsigned* st) {
    XcdBarrier b; b.bar = bar; b.x = xb_xcc_id(); b.st = st;
    if (threadIdx.x == 0) (void)xb_add(&bar[XB_XCNT(b.x)], 1u);
    return b;
}
DI void xcd_barrier_complete(unsigned* bar, unsigned x, unsigned& nloc, unsigned& nx) {
    const unsigned G = gridDim.x * gridDim.y * gridDim.z;
    unsigned sum, cnt, mine, sp = 0u;
    for (;;) {
        sum = 0u; cnt = 0u; mine = 0u;
#pragma unroll
        for (unsigned j = 0; j < 16; ++j) { const unsigned c = xb_ld(&bar[XB_XCNT(j)]); sum += c; cnt += (c > 0u) ? 1u : 0u; mine = (j == x) ? c : mine; }
        if (sum == G) break;
        __builtin_amdgcn_s_sleep(1);
        if ((++sp & 255u) == 0u) { if (xb_ld(&bar[XB_TMO])) break; if (sp > XB_SPIN_CAP) { atomicAdd(&bar[XB_TMO], 1u); break; } }
    }
    nloc = mine > 0u ? mine : 1u; nx = cnt > 0u ? cnt : 1u;
}
DI void xcd_barrier(const XcdBarrier& b) {
    asm volatile("s_waitcnt vmcnt(0)" ::: "memory");
    __syncthreads();
    if (threadIdx.x == 0) {
        unsigned* bar = b.bar;
        __builtin_amdgcn_s_waitcnt(0);
        unsigned nloc = b.st[0], nx = b.st[1];
        if (nloc == 0u) { xcd_barrier_complete(bar, b.x, nloc, nx); b.st[0] = nloc; b.st[1] = nx; }
        const unsigned old = xb_add(&bar[XB_XSUB(b.x)], 1u);
        const unsigned gen = old / nloc;
        if (old + 1u == (gen + 1u) * nloc) {
            __builtin_amdgcn_fence(__ATOMIC_RELEASE, "agent");
            asm volatile("s_waitcnt vmcnt(0)" ::: "memory");
            const unsigned og = xb_add(&bar[XB_TOP], 1u);
            const unsigned tg = og / nx;
            if (og + 1u == (tg + 1u) * nx) xb_add(&bar[XB_TOPGEN], 1u);
            else XB_SPIN(xb_ld(&bar[XB_TOPGEN]) == tg, bar);
            __builtin_amdgcn_fence(__ATOMIC_ACQUIRE, "agent");
            xb_add(&bar[XB_XGEN(b.x)], 1u);
            asm volatile("s_waitcnt vmcnt(0)" ::: "memory");
        } else {
            XB_SPIN(xb_ld(&bar[XB_XGEN(b.x)]) == gen, bar);
            __builtin_amdgcn_fence(__ATOMIC_ACQUIRE, "agent");
            asm volatile("s_waitcnt vmcnt(0)" ::: "memory");
        }
    }
    __syncthreads();
}

__global__ void __launch_bounds__(512, 2) fwd_megakernel(Params p) {
    extern __shared__ __attribute__((aligned(16))) unsigned char lds_raw[];
    LAS unsigned char* lds = (LAS unsigned char*)lds_raw;
    cg::grid_group grid = cg::this_grid();
    const int tid = threadIdx.x, lane = tid & 63, wave = __builtin_amdgcn_readfirstlane(tid >> 6);
    const int G = gridDim.x, bx = blockIdx.x;
    const int gw = bx * 8 + wave, NGW = G * 8;
    unsigned char* ws = p.ws;
    const int lo = p.ph_lo, hi = p.ph_hi;
#define IN(k) (lo <= (k) && (k) < hi)
#define SEAM(k) do { if (IN(k) && IN((k) + 1)) { if ((k) == 0) grid.sync(); else xcd_barrier(xbar); } } while (0)
    volatile LAS unsigned* misc = (volatile LAS unsigned*)(lds + MISC_OFF);
    if (tid < 16) misc[tid] = 0u;
    __syncthreads();
    const XcdBarrier xbar = xcd_barrier_post((unsigned*)ws, misc + 8);
    bf16_t* XN = (bf16_t*)(ws + WS_XN); bf16_t* Wt_in = (bf16_t*)(ws + WS_WIN);

    if (IN(0)) { p0_prologue(p, lds, gw, NGW, wave, lane); }
    SEAM(0);
    if (IN(1)) {
        { pg8::Gemm g{XN, Wt_in, M, NMAIN, D, D}; pg8::StaticOrder S; S.init(M, NMAIN, G, bx);
          EpiProj E{(bf16_t*)(ws + WS_Q), (bf16_t*)(ws + WS_K), (bf16_t*)(ws + WS_UBC), (bf16_t*)(ws + WS_G), p.in[4]};
          pg8::gemm_phase<EpiProj, pg8::StaticOrder, true>(lds, g, S, E); }
        { pg8::Gemm g{Wt_in + (size_t)NMAIN * D, XN, DA, M, D, D}; pg8::StaticOrder S; S.init(DA, M, G, bx);
          EpiVT E{(bf16_t*)(ws + WS_VT)};
          pg8::gemm_phase<EpiVT, pg8::StaticOrder, true>(lds, g, S, E); }
    }
    SEAM(1);
    if (IN(2)) { p2_conv(p, bx * 512 + tid, G * 512); p2_attention(p, lds, tid, wave, lane, G, bx); __syncthreads(); }
    SEAM(2);
    if (IN(3)) {
        { pg8::Gemm g{(bf16_t*)(ws + WS_AC), (bf16_t*)(ws + WS_WA), M, D, DA, D}; pg8::StaticOrder S; S.init(M, D, G, bx);
          EpiBranch E{(bf16_t*)(ws + WS_MG), (const bf16_t*)(ws + WS_G), 0};
          pg8::gemm_phase<EpiBranch, pg8::StaticOrder, true>(lds, g, S, E); }
        { pg8::Gemm g{(bf16_t*)(ws + WS_AC) + DA, (bf16_t*)(ws + WS_WC), M, D, DA, D}; pg8::StaticOrder S; S.init(M, D, G, bx);
          EpiBranch E{(bf16_t*)(ws + WS_MG), (const bf16_t*)(ws + WS_G), 1};
          pg8::gemm_phase<EpiBranch, pg8::StaticOrder, true>(lds, g, S, E); }
    }
    SEAM(3);
    if (IN(4)) {
        pg8::Gemm g{(bf16_t*)(ws + WS_MG), (bf16_t*)(ws + WS_WOUT), M, D, D, D}; pg8::StaticOrder S; S.init(M, D, G, bx);
        EpiResid E{p.in[0], p.in[1], p.out, (bf16_t*)(ws + WS_X1B), (float*)(ws + WS_RSQ1), 0};
        pg8::gemm_phase<EpiResid, pg8::StaticOrder, true>(lds, g, S, E);
    }
    SEAM(4);
    if (IN(5)) {
        pg8::Gemm g{(bf16_t*)(ws + WS_X1B), (bf16_t*)(ws + WS_WFI), M, 2 * DFF, D, D}; pg8::StaticOrder S; S.init(M, 2 * DFF, G, bx);
        EpiFfnIn E{(bf16_t*)(ws + WS_ACT), (const float*)(ws + WS_RSQ1)};
        pg8::gemm_phase<EpiFfnIn, pg8::StaticOrder, true>(lds, g, S, E);
    }
    SEAM(5);
    if (IN(6)) {
        pg8::Gemm g{(bf16_t*)(ws + WS_ACT), (bf16_t*)(ws + WS_WFD), M, D, DFF, DFF}; pg8::StaticOrder S; S.init(M, D, G, bx);
        EpiResid E{nullptr, nullptr, p.out, nullptr, (float*)(ws + WS_RSQ2), 1};
        pg8::gemm_phase<EpiResid, pg8::StaticOrder, true>(lds, g, S, E);
    }
    SEAM(6);
    if (IN(7)) { p7_final(p, gw, NGW, lane); }
#undef IN
#undef SEAM
}

extern "C" void kernel_launch(void* const* d_in, const int* in_sizes, int n_in, void* d_out, int out_size, void* d_ws, size_t ws_size, hipStream_t stream) {
    static int grid_blocks = 0;
    if (grid_blocks == 0) {
        if (n_in != 14 || in_sizes[0] != MP * D || in_sizes[1] != (M - MP) * D || out_size != M * D || ws_size < WS_END) {
            fprintf(stderr, "kernel_launch: unexpected shapes / workspace (n_in %d, ws %zu); nothing launched\n", n_in, ws_size); grid_blocks = -1; return; }
        int dev = 0, cus = 0, per_cu = 0;
        (void)hipGetDevice(&dev);
        (void)hipDeviceGetAttribute(&cus, hipDeviceAttributeMultiprocessorCount, dev);
        (void)hipFuncSetAttribute((const void*)fwd_megakernel, hipFuncAttributeMaxDynamicSharedMemorySize, LDS_BYTES);
        (void)hipOccupancyMaxActiveBlocksPerMultiprocessor(&per_cu, (const void*)fwd_megakernel, 512, LDS_BYTES);
        (void)hipGetLastError();
        if (per_cu < 1) per_cu = 1;
        grid_blocks = cus * per_cu;
    }
    if (grid_blocks < 0) return;
    if (hipMemsetAsync(d_ws, 0, 16384, stream) != hipSuccess) { fprintf(stderr, "kernel_launch: memset of the barrier words failed\n"); return; }
    Params p{};
    for (int i = 0; i < 14; ++i) p.in[i] = (const float*)d_in[i];
    p.out = (float*)d_out; p.ws = (unsigned char*)d_ws; p.ph_lo = 0; p.ph_hi = 8;
    void* args[] = {&p};
    hipError_t e = hipLaunchCooperativeKernel((const void*)fwd_megakernel, dim3(grid_blocks), dim3(512), args, LDS_BYTES, stream);
    if (e != hipSuccess) fprintf(stderr, "cooperative launch failed: %s (grid %d)\n", hipGetErrorString(e), grid_blocks);
}
```

```cpp
#include <hip/hip_runtime.h>
#include <hip/hip_cooperative_groups.h>
#include <cstdio>
#include <cstdint>
namespace cg = cooperative_groups;

#define DI __device__ __forceinline__
#define LAS __attribute__((address_space(3)))
typedef unsigned short bf16_t;
typedef short bf16x8 __attribute__((ext_vector_type(8)));
typedef short s16x4 __attribute__((ext_vector_type(4)));
typedef float f32x4 __attribute__((ext_vector_type(4)));
typedef float f32x2 __attribute__((ext_vector_type(2)));
typedef unsigned u32x4 __attribute__((ext_vector_type(4)));
typedef unsigned u32x2 __attribute__((ext_vector_type(2)));
typedef __bf16 bf16x2n __attribute__((ext_vector_type(2)));

constexpr int M = 81920, MP = 65536, D = 1024, DA = 512, DFF = 2816, SEQ = 8192;
constexpr int NIN = 5120, NMAIN = 4608;
constexpr float RMS_EPS = 1e-6f, LOG2E = 1.4426950408889634f;
constexpr float QSCALE = 0.125f * LOG2E;
constexpr size_t MiB = 1u << 20;
constexpr size_t WS_WIN = 1 * MiB, WS_WA = 11 * MiB, WS_WC = 12 * MiB, WS_WOUT = 13 * MiB, WS_WFI = 15 * MiB, WS_WFD = 26 * MiB;
constexpr size_t WS_RSQ1 = 32 * MiB, WS_RSQ2 = 38 * MiB;
constexpr size_t WS_G = 44 * MiB, WS_Q = 364 * MiB, WS_K = 444 * MiB, WS_VT = 524 * MiB, WS_UBC = 604 * MiB, WS_XN = 844 * MiB;
constexpr size_t WS_AC = WS_XN, WS_MG = WS_Q, WS_X1B = WS_VT, WS_ACT = WS_G, WS_END = 1004 * MiB;
constexpr int LDS_BYTES = 147456, MISC_OFF = 143360;

DI unsigned pk2(float lo, float hi) { f32x2 v = {lo, hi}; return __builtin_bit_cast(unsigned, __builtin_convertvector(v, bf16x2n)); }
DI float bf_lo(unsigned w) { return __uint_as_float(w << 16); }
DI float bf_hi(unsigned w) { return __uint_as_float(w & 0xffff0000u); }
DI float fast_sigmoid(float v) { return __builtin_amdgcn_rcpf(1.0f + __builtin_amdgcn_exp2f(-v * LOG2E)); }

namespace pg8 {
constexpr int BM = 256, BK = 64, HALF = 128, HTB = HALF * BK * 2, STAGE_BYTES = 8 * HTB, NXCD = 8, WGM = 8;
DI int lds_byte(int r, int c) { const int st = (r >> 4) * 2 + (c >> 5), rr = r & 15, cc = c & 31, ob = rr * 64 + cc * 2; return st * 1024 + (ob ^ (((ob >> 9) & 1) << 5)); }
DI void stage_rc(int b, int& R, int& C) { const int st = b / 1024, sb = b % 1024, swz = sb ^ (((sb >> 9) & 1) << 5); R = (st >> 1) * 16 + swz / 64; C = (st & 1) * 32 + (swz % 64) / 2; }
DI int perm32(int rho) { const int n = rho >> 4, i = rho & 15; return 8 * (i >> 2) + 4 * n + (i & 3); }

struct Unit { int pm, pn, kind; };
struct Gemm { const bf16_t* A; const bf16_t* Bt; int M, N, K, lda; };

struct StaticOrder {
    int nM, nN, nwg, G, c;
    DI void init(int M_, int N_, int G_, int c_) { nM = M_ / BM; nN = N_ / BM; nwg = nM * nN; G = G_; c = c_; }
    DI bool next(int i, Unit& u) const {
        const long L = (long)i * G + c; if (L >= nwg) return false;
        int wgid = (int)L; { const int q = nwg / NXCD, r = nwg % NXCD, xcd = wgid % NXCD, off = wgid / NXCD; wgid = (xcd < r ? xcd * (q + 1) : r * (q + 1) + (xcd - r) * q) + off; }
        const int nig = WGM * nN, gid = wgid / nig, fm = gid * WGM, gsz = (nM - fm) < WGM ? (nM - fm) : WGM;
        u.pm = fm + ((wgid % nig) % gsz); u.pn = (wgid % nig) / gsz; u.kind = 0; return true;
    }
    DI const char* a_ptr(const Gemm& g, const Unit& u, size_t tstepA) const { return (const char*)g.A + (size_t)u.pm * tstepA; }
    DI const char* b_ptr(const Gemm& g, const Unit& u, size_t tstepB) const { return (const char*)g.Bt + (size_t)u.pn * tstepB; }
};
struct DualOrder {
    StaticOrder s0, s1; const bf16_t* A1; const bf16_t* Bt1;
    DI bool next(int i, Unit& u) const {
        const long L = (long)i * s0.G + s0.c;
        if (L < s0.nwg) return s0.next(i, u);
        const long L1 = L - s0.nwg; if (L1 >= s1.nwg) return false;
        StaticOrder t = s1; t.c = (int)(L1 % s1.G); const bool ok = t.next((int)(L1 / s1.G), u); u.kind = 1; return ok;
    }
    DI const char* a_ptr(const Gemm& g, const Unit& u, size_t tstepA) const { return (const char*)(u.kind ? A1 : g.A) + (size_t)u.pm * tstepA; }
    DI const char* b_ptr(const Gemm& g, const Unit& u, size_t tstepB) const { return (const char*)(u.kind ? Bt1 : g.Bt) + (size_t)u.pn * tstepB; }
};

template <class Epi, class Sched, bool ALIGN_EPI>
DI void gemm_phase(LAS unsigned char* lds, const Gemm g, const Sched& S, const Epi& E) {
    const int tid = threadIdx.x, wid = __builtin_amdgcn_readfirstlane(tid >> 6), lane = tid & 63, wr = wid >> 2, wc = wid & 3, fr = lane & 15, fq = lane >> 4;
    const int K = g.K, nt = K / BK, lda = g.lda;
    unsigned voffA[2], voffB[2];
#pragma unroll
    for (int i = 0; i < 2; ++i) { int R, C; stage_rc(tid * 16 + i * 8192, R, C); const int Rb = Epi::PERM ? ((R & ~31) + perm32(R & 31)) : R;
        voffA[i] = (unsigned)(R * lda + C) * 2u; voffB[i] = (unsigned)(Rb * K + C) * 2u; }
    const size_t kstep = (size_t)(BK * 2);
    const size_t hstepA = (size_t)HALF * lda * 2, hstepB = (size_t)HALF * K * 2;
    const size_t tstepA = 2 * hstepA, tstepB = 2 * hstepB;
    const unsigned ldsw = (unsigned)wid * 1024u;
    const int aoff = lds_byte(wr * 64 + fr, fq * 8), boff = lds_byte(wc * 32 + fr, fq * 8);
#define PG8_SA(b, h) (((b) * 2 + (h)) * HTB)
#define PG8_SB(b, h) ((4 + (b) * 2 + (h)) * HTB)
#define PG8_STAGE(bufoff, gbase, voff) do { _Pragma("unroll") for (int _i = 0; _i < 2; ++_i) \
        __builtin_amdgcn_global_load_lds((const unsigned*)((const char*)(gbase) + (voff)[_i]), (LAS unsigned*)(lds + (bufoff) + ldsw + _i * 8192), 16, 0, 0); } while (0)
#define PG8_LDA(dst, b, h) do { _Pragma("unroll") for (int m = 0; m < 4; ++m) _Pragma("unroll") for (int k = 0; k < 2; ++k) dst[m][k] = *(const LAS bf16x8*)(lds + PG8_SA(b, h) + aoff + m * 2048 + k * 1024); } while (0)
#define PG8_LDB(dst, b, h) do { _Pragma("unroll") for (int n = 0; n < 2; ++n) _Pragma("unroll") for (int k = 0; k < 2; ++k) dst[n][k] = *(const LAS bf16x8*)(lds + PG8_SB(b, h) + boff + n * 2048 + k * 1024); } while (0)
#define PG8_MMA(ai, bj, At, Bt) do { __builtin_amdgcn_s_setprio(1); _Pragma("unroll") for (int m = 0; m < 4; ++m) _Pragma("unroll") for (int n = 0; n < 2; ++n) _Pragma("unroll") for (int k = 0; k < 2; ++k) \
        acc[ai][bj][m][n] = __builtin_amdgcn_mfma_f32_16x16x32_bf16(Bt[n][k], At[m][k], acc[ai][bj][m][n], 0, 0, 0); __builtin_amdgcn_s_setprio(0); } while (0)
#define PG8_WAIT_V(n) asm volatile("s_waitcnt vmcnt(" #n ")" ::: "memory")
#define PG8_WAIT_L(n) asm volatile("s_waitcnt lgkmcnt(" #n ")" ::: "memory")
#define PG8_BAR __builtin_amdgcn_s_barrier()
#define PG8_SCHED __builtin_amdgcn_sched_barrier(0)
    Unit cur, nxt; int ui = 0;
    if (!S.next(0, cur)) return;
    f32x4 acc[2][2][4][2];
#pragma unroll
    for (int a = 0; a < 2; ++a)
#pragma unroll
        for (int b = 0; b < 2; ++b)
#pragma unroll
            for (int m = 0; m < 4; ++m)
#pragma unroll
                for (int n = 0; n < 2; ++n) acc[a][b][m][n] = (f32x4){0.f, 0.f, 0.f, 0.f};
    bf16x8 At[4][2], B0[2][2], B1[2][2];
    const char* cA = S.a_ptr(g, cur, tstepA); const char* cB = S.b_ptr(g, cur, tstepB);
    PG8_STAGE(PG8_SB(0, 0), cB, voffB); PG8_STAGE(PG8_SB(0, 1), cB + hstepB, voffB); PG8_STAGE(PG8_SA(0, 0), cA, voffA); PG8_STAGE(PG8_SA(0, 1), cA + hstepA, voffA);
    if (wr == 1) PG8_BAR;
    PG8_WAIT_V(2); PG8_BAR;
    PG8_STAGE(PG8_SB(1, 0), cB + kstep, voffB); PG8_STAGE(PG8_SA(1, 0), cA + kstep, voffA); PG8_STAGE(PG8_SB(1, 1), cB + hstepB + kstep, voffB);
    PG8_WAIT_V(6); PG8_BAR;
    for (;;) {
        const bool has_next = S.next(ui + 1, nxt);
        const char* nA = has_next ? S.a_ptr(g, nxt, tstepA) : cA; const char* nB = has_next ? S.b_ptr(g, nxt, tstepB) : cB;
        for (int t = 0; t < nt; t += 2) {
            const bool last = (t == nt - 2);
            const char* a1 = cA + (size_t)(t + 1) * kstep;
            const char* a2 = last ? nA : cA + (size_t)(t + 2) * kstep; const char* b2 = last ? nB : cB + (size_t)(t + 2) * kstep;
            const char* a3 = a2 + kstep; const char* b3 = b2 + kstep;
            if constexpr (Epi::MID) { if (t == (nt >> 1)) E.mid(acc, cur, wr, wc, fr, fq); }
            PG8_LDB(B0, 0, 0); PG8_LDB(B1, 0, 1); PG8_SCHED; PG8_LDA(At, 0, 0); PG8_STAGE(PG8_SA(1, 1), a1 + hstepA, voffA);
            PG8_WAIT_V(8); PG8_WAIT_L(0); PG8_BAR; PG8_MMA(0, 0, At, B0); PG8_MMA(0, 1, At, B1); PG8_BAR; PG8_SCHED;
            PG8_LDA(At, 0, 1); PG8_STAGE(PG8_SB(0, 0), b2, voffB); PG8_STAGE(PG8_SB(0, 1), b2 + hstepB, voffB); PG8_STAGE(PG8_SA(0, 0), a2, voffA);
            PG8_WAIT_V(8); PG8_WAIT_L(0); PG8_BAR; PG8_MMA(1, 0, At, B0); PG8_MMA(1, 1, At, B1); PG8_BAR; PG8_SCHED;
            PG8_LDB(B0, 1, 0); PG8_LDB(B1, 1, 1); PG8_SCHED; PG8_LDA(At, 1, 0); PG8_STAGE(PG8_SA(0, 1), a2 + hstepA, voffA);
            PG8_WAIT_V(8); PG8_WAIT_L(0); PG8_BAR; PG8_MMA(0, 0, At, B0); PG8_MMA(0, 1, At, B1); PG8_BAR; PG8_SCHED;
            PG8_LDA(At, 1, 1); PG8_STAGE(PG8_SB(1, 0), b3, voffB); PG8_STAGE(PG8_SB(1, 1), b3 + hstepB, voffB); PG8_STAGE(PG8_SA(1, 0), a3, voffA);
            PG8_WAIT_V(8); PG8_WAIT_L(0); PG8_BAR; PG8_MMA(1, 0, At, B0); PG8_MMA(1, 1, At, B1); PG8_BAR; PG8_SCHED;
        }
        if constexpr (ALIGN_EPI) { if (wr == 0) PG8_BAR; }
        E(acc, cur, wr, wc, fr, fq);
        if (!has_next) break;
#pragma unroll
        for (int a = 0; a < 2; ++a)
#pragma unroll
            for (int b = 0; b < 2; ++b)
#pragma unroll
                for (int m = 0; m < 4; ++m)
#pragma unroll
                    for (int n = 0; n < 2; ++n) acc[a][b][m][n] = (f32x4){0.f, 0.f, 0.f, 0.f};
        cur = nxt; cA = nA; cB = nB; ++ui;
        if constexpr (ALIGN_EPI) { if (wr == 1) PG8_BAR; }
    }
    PG8_WAIT_V(0);
    if constexpr (!ALIGN_EPI) { if (wr == 0) PG8_BAR; }
    PG8_BAR;
#undef PG8_SA
#undef PG8_SB
#undef PG8_STAGE
#undef PG8_LDA
#undef PG8_LDB
#undef PG8_MMA
#undef PG8_WAIT_V
#undef PG8_WAIT_L
#undef PG8_BAR
#undef PG8_SCHED
}
}
using pg8::Unit;

struct EpiProj {
    static constexpr bool MID = false;
    static constexpr bool PERM = true;
    bf16_t *Q, *K, *UBC, *G; const float* bgate;
    DI void operator()(const f32x4 (&acc)[2][2][4][2], const Unit& u, int wr, int wc, int fr, int fq) const {
        const int row0 = u.pm * 256 + wr * 64 + fr, cl = wc * 32 + 8 * fq, pn = u.pn;
        bf16_t* base; int ld; float sc = 1.f; bool gate = false; int gcol = 0;
        if (pn < 2) { base = Q + pn * 256; ld = 512; sc = QSCALE; }
        else if (pn < 4) { base = K + (pn - 2) * 256; ld = 512; }
        else if (pn < 10) { base = UBC + (pn - 4) * 256; ld = 1536; }
        else { base = G; ld = 0; gate = true; gcol = (pn - 10) * 256; }
        f32x4 bv[2][2];
#pragma unroll
        for (int bj = 0; bj < 2; ++bj)
#pragma unroll
            for (int n = 0; n < 2; ++n) bv[bj][n] = gate ? *(const f32x4*)(bgate + gcol + cl + bj * 128 + 4 * n) : (f32x4){0.f, 0.f, 0.f, 0.f};
#pragma unroll
        for (int ai = 0; ai < 2; ++ai)
#pragma unroll
            for (int m = 0; m < 4; ++m) { bf16_t* rowp = base + (size_t)(row0 + ai * 128 + m * 16) * ld + cl;
#pragma unroll
                for (int bj = 0; bj < 2; ++bj) { f32x4 v0 = acc[ai][bj][m][0] + bv[bj][0], v1 = acc[ai][bj][m][1] + bv[bj][1];
                    if (gate) {
                        unsigned q0[4], q1[4];
#pragma unroll
                        for (int e = 0; e < 4; ++e) { q0[e] = (unsigned)fmaxf(fast_sigmoid(v0[e]) * 255.0f + 0.5f, 1.0f); q1[e] = (unsigned)fmaxf(fast_sigmoid(v1[e]) * 255.0f + 0.5f, 1.0f); }
                        u32x2 w; w.x = q0[0] | (q0[1] << 8) | (q0[2] << 16) | (q0[3] << 24); w.y = q1[0] | (q1[1] << 8) | (q1[2] << 16) | (q1[3] << 24);
                        *(u32x2*)((unsigned char*)G + (size_t)(row0 + ai * 128 + m * 16) * 2048 + gcol + cl + bj * 128) = w;
                    } else { v0 = v0 * sc; v1 = v1 * sc;
                        u32x4 w; w.x = pk2(v0[0], v0[1]); w.y = pk2(v0[2], v0[3]); w.z = pk2(v1[0], v1[1]); w.w = pk2(v1[2], v1[3]);
                        *(u32x4*)(rowp + bj * 128) = w; } } }
    }
};
struct EpiVT {
    static constexpr bool MID = false;
    static constexpr bool PERM = true;
    bf16_t* VT;
    DI void operator()(const f32x4 (&acc)[2][2][4][2], const Unit& u, int wr, int wc, int fr, int fq) const {
        const int ch0 = u.pm * 256 + wr * 64 + fr, tokl = u.pn * 256 + wc * 32 + 8 * fq;
#pragma unroll
        for (int ai = 0; ai < 2; ++ai)
#pragma unroll
            for (int m = 0; m < 4; ++m) { const int ch = ch0 + ai * 128 + m * 16, h = ch >> 6, d = ch & 63;
#pragma unroll
                for (int bj = 0; bj < 2; ++bj) { const int tok = tokl + bj * 128, b = tok >> 13, t = tok & 8191, row = t >> 6, col = t & 63;
                    const f32x4 v0 = acc[ai][bj][m][0], v1 = acc[ai][bj][m][1];
                    u32x4 w; w.x = pk2(v0[0], v0[1]); w.y = pk2(v0[2], v0[3]); w.z = pk2(v1[0], v1[1]); w.w = pk2(v1[2], v1[3]);
                    *(u32x4*)(VT + ((((size_t)(b * 8 + h) * 128 + row) * 64 + d) * 64 + col)) = w; } }
    }
};
struct EpiP1 {
    static constexpr bool PERM = true, MID = false;
    EpiProj ep; EpiVT ev;
    DI void operator()(const f32x4 (&acc)[2][2][4][2], const Unit& u, int wr, int wc, int fr, int fq) const { if (u.kind) ev(acc, u, wr, wc, fr, fq); else ep(acc, u, wr, wc, fr, fq); }
};
struct EpiMerge {
    static constexpr bool PERM = true, MID = true;
    bf16_t* MG; const unsigned char* G;
    DI void mid(f32x4 (&acc)[2][2][4][2], const Unit& u, int wr, int wc, int fr, int fq) const {
        int row0 = u.pm * 256 + wr * 64 + fr, c0 = u.pn * 256 + wc * 32 + 8 * fq;
        asm volatile("" : "+v"(row0), "+v"(c0));
#pragma unroll
        for (int ai = 0; ai < 2; ++ai) {
            u32x2 ga[4][2], gc[4][2];
#pragma unroll
            for (int m = 0; m < 4; ++m)
#pragma unroll
                for (int bj = 0; bj < 2; ++bj) { const unsigned char* gp = G + (size_t)(row0 + ai * 128 + m * 16) * 2048 + c0 + bj * 128;
                    ga[m][bj] = *(const u32x2*)gp; gc[m][bj] = *(const u32x2*)(gp + 1024); }
#pragma unroll
            for (int m = 0; m < 4; ++m)
#pragma unroll
                for (int bj = 0; bj < 2; ++bj) { const u32x2 a = ga[m][bj], c = gc[m][bj];
#pragma unroll
                    for (int e = 0; e < 4; ++e) {
                        acc[ai][bj][m][0][e] *= (float)((a.x >> (8 * e)) & 0xffu) * __builtin_amdgcn_rcpf((float)((c.x >> (8 * e)) & 0xffu));
                        acc[ai][bj][m][1][e] *= (float)((a.y >> (8 * e)) & 0xffu) * __builtin_amdgcn_rcpf((float)((c.y >> (8 * e)) & 0xffu)); } }
            asm volatile("" ::: "memory");
        }
    }
    DI void operator()(const f32x4 (&acc)[2][2][4][2], const Unit& u, int wr, int wc, int fr, int fq) const {
        const int row0 = u.pm * 256 + wr * 64 + fr, c0 = u.pn * 256 + wc * 32 + 8 * fq;
        constexpr float I255 = 1.0f / 255.0f;
        u32x2 gc[2][4][2];
#pragma unroll
        for (int ai = 0; ai < 2; ++ai)
#pragma unroll
            for (int m = 0; m < 4; ++m)
#pragma unroll
                for (int bj = 0; bj < 2; ++bj) gc[ai][m][bj] = *(const u32x2*)(G + (size_t)(row0 + ai * 128 + m * 16) * 2048 + 1024 + c0 + bj * 128);
#pragma unroll
        for (int ai = 0; ai < 2; ++ai)
#pragma unroll
            for (int m = 0; m < 4; ++m)
#pragma unroll
                for (int bj = 0; bj < 2; ++bj) { const u32x2 c = gc[ai][m][bj];
                    f32x4 v0 = acc[ai][bj][m][0], v1 = acc[ai][bj][m][1];
#pragma unroll
                    for (int e = 0; e < 4; ++e) { v0[e] *= (float)((c.x >> (8 * e)) & 0xffu) * I255; v1[e] *= (float)((c.y >> (8 * e)) & 0xffu) * I255; }
                    u32x4 w; w.x = pk2(v0[0], v0[1]); w.y = pk2(v0[2], v0[3]); w.z = pk2(v1[0], v1[1]); w.w = pk2(v1[2], v1[3]);
                    *(u32x4*)(MG + (size_t)(row0 + ai * 128 + m * 16) * 1024 + c0 + bj * 128) = w; }
    }
};
struct EpiResid {
    static constexpr bool MID = false;
    static constexpr bool PERM = false;
    const float* xp; const float* xs; bf16_t* XB; float* RSQ; int inplace;
    DI void operator()(const f32x4 (&acc)[2][2][4][2], const Unit& u, int wr, int wc, int fr, int fq) const {
        const int row0 = u.pm * 256 + wr * 64 + fr, c0 = u.pn * 256 + wc * 32 + 4 * fq;
#pragma unroll
        for (int ai = 0; ai < 2; ++ai) {
            f32x4 xv[4][2][2];
            if (inplace) {
#pragma unroll
                for (int m = 0; m < 4; ++m) { const bf16_t* bp = XB + (size_t)(row0 + ai * 128 + m * 16) * 1024 + c0;
#pragma unroll
                    for (int bj = 0; bj < 2; ++bj)
#pragma unroll
                        for (int n = 0; n < 2; ++n) { const u32x2 w = *(const u32x2*)(bp + bj * 128 + n * 16); xv[m][bj][n] = (f32x4){bf_lo(w.x), bf_hi(w.x), bf_lo(w.y), bf_hi(w.y)}; } }
            } else {
#pragma unroll
                for (int m = 0; m < 4; ++m) { const int row = row0 + ai * 128 + m * 16;
                    const float* bp = (row < MP ? xp + (size_t)row * 1024 : xs + (size_t)(row - MP) * 1024) + c0;
#pragma unroll
                    for (int bj = 0; bj < 2; ++bj)
#pragma unroll
                        for (int n = 0; n < 2; ++n) xv[m][bj][n] = *(const f32x4*)(bp + bj * 128 + n * 16); }
            }
#pragma unroll
            for (int m = 0; m < 4; ++m) { const int row = row0 + ai * 128 + m * 16;
                float ss = 0.f;
#pragma unroll
                for (int bj = 0; bj < 2; ++bj)
#pragma unroll
                    for (int n = 0; n < 2; ++n) { const int c = c0 + bj * 128 + n * 16;
                        const f32x4 o = xv[m][bj][n] + acc[ai][bj][m][n];
                        u32x2 w; w.x = pk2(o[0], o[1]); w.y = pk2(o[2], o[3]); *(u32x2*)(XB + (size_t)row * 1024 + c) = w;
                        ss += (o[0] * o[0] + o[1] * o[1]) + (o[2] * o[2] + o[3] * o[3]); }
                ss += __shfl_xor(ss, 16); ss += __shfl_xor(ss, 32);
                if (fq == 0) RSQ[(size_t)row * 16 + u.pn * 4 + wc] = ss; }
        }
    }
};
struct EpiFfnIn {
    static constexpr bool MID = false;
    static constexpr bool PERM = true;
    bf16_t* ACT; const float* RSQ;
    DI void operator()(const f32x4 (&acc)[2][2][4][2], const Unit& u, int wr, int wc, int fr, int fq) const {
        const int row0 = u.pm * 256 + wr * 64 + fr, c0 = u.pn * 128 + wc * 32 + 8 * fq;
        f32x4 pr[2][4];
#pragma unroll
        for (int ai = 0; ai < 2; ++ai)
#pragma unroll
            for (int m = 0; m < 4; ++m) pr[ai][m] = *(const f32x4*)(RSQ + (size_t)(row0 + ai * 128 + m * 16) * 16 + 4 * fq);
#pragma unroll
        for (int ai = 0; ai < 2; ++ai)
#pragma unroll
            for (int m = 0; m < 4; ++m) { const size_t row = (size_t)(row0 + ai * 128 + m * 16);
                const f32x4 q = pr[ai][m];
                float s = (q[0] + q[1]) + (q[2] + q[3]); s += __shfl_xor(s, 16); s += __shfl_xor(s, 32);
                const float rs = 1.0f / sqrtf(s * (1.0f / 1024.0f) + RMS_EPS);
                float o[8];
#pragma unroll
                for (int n = 0; n < 2; ++n)
#pragma unroll
                    for (int e = 0; e < 4; ++e) { const float gt = acc[ai][0][m][n][e] * rs, up = acc[ai][1][m][n][e] * rs; o[4 * n + e] = gt * fast_sigmoid(gt) * up; }
                u32x4 w; w.x = pk2(o[0], o[1]); w.y = pk2(o[2], o[3]); w.z = pk2(o[4], o[5]); w.w = pk2(o[6], o[7]);
                *(u32x4*)(ACT + row * DFF + c0) = w; }
    }
};

DI float wave_sum(float v) {
#pragma unroll
    for (int o = 1; o < 64; o <<= 1) v += __shfl_xor(v, o);
    return v;
}
DI void transpose_item(const float* W, int K, int N, int srccol0, const float* ks, bf16_t* WT, int dstrow0, int kb, LAS float* scr, int lane, int ldw = 0, int koff = 0) {
    if (ldw == 0) ldw = K;
    const int k0 = 64 * kb;
#pragma unroll 8
    for (int i = 0; i < 32; ++i) { const int kk = 2 * i + (lane >> 5); float v = W[(size_t)(k0 + kk) * N + srccol0 + (lane & 31)]; if (ks) v *= ks[k0 + kk]; scr[kk * 33 + (lane & 31)] = v; }
    asm volatile("s_waitcnt lgkmcnt(0)" ::: "memory");
    const int c = lane & 7;
#pragma unroll
    for (int j = 0; j < 4; ++j) { const int n = (lane >> 3) + 8 * j; const LAS float* s = scr + (8 * c) * 33 + n;
        u32x4 o; o.x = pk2(s[0 * 33], s[1 * 33]); o.y = pk2(s[2 * 33], s[3 * 33]); o.z = pk2(s[4 * 33], s[5 * 33]); o.w = pk2(s[6 * 33], s[7 * 33]);
        *(u32x4*)(WT + (size_t)(dstrow0 + n) * ldw + koff + k0 + 8 * c) = o; }
    asm volatile("s_waitcnt lgkmcnt(0)" ::: "memory");
}

struct Params { const float* in[14]; float* out; unsigned char* ws; int ph_lo, ph_hi; };

DI void p0_prologue(const Params& p, LAS unsigned char* lds, int gw, int NGW, int wave, int lane) {
    unsigned char* ws = p.ws;
    LAS float* scr = (LAS float*)(lds + wave * 16384);
    const float *w_in = p.in[3], *wa = p.in[7], *wc = p.in[8], *wout = p.in[9], *gffn = p.in[10], *wfi = p.in[11], *wfd = p.in[12];
    constexpr int I_IN = 16 * (NIN / 32), I_A = 8 * 32, I_C = 8 * 32, I_O = 16 * 32, I_FI = 16 * (2 * DFF / 32), I_FD = (DFF / 64) * 32;
    constexpr int NITEMS = I_IN + I_A + I_C + I_O + I_FI + I_FD;
    for (int it = gw; it < NITEMS; it += NGW) {
        int r = it;
        if (r < I_IN) { const int nblk = NIN / 32, kb = r / nblk, n0 = 32 * (r % nblk);
            const int src = n0 < 1024 ? n0 : (n0 < NMAIN ? n0 + 512 : n0 - NMAIN + 1024);
            transpose_item(w_in, D, NIN, src, nullptr, (bf16_t*)(ws + WS_WIN), n0, kb, scr, lane); continue; } r -= I_IN;
        if (r < I_A) { transpose_item(wa, DA, D, 32 * (r % 32), nullptr, (bf16_t*)(ws + WS_WA), 32 * (r % 32), r / 32, scr, lane, D, 0); continue; } r -= I_A;
        if (r < I_C) { transpose_item(wc, DA, D, 32 * (r % 32), nullptr, (bf16_t*)(ws + WS_WA), 32 * (r % 32), r / 32, scr, lane, D, DA); continue; } r -= I_C;
        if (r < I_O) { transpose_item(wout, D, D, 32 * (r % 32), nullptr, (bf16_t*)(ws + WS_WOUT), 32 * (r % 32), r / 32, scr, lane); continue; } r -= I_O;
        if (r < I_FI) { const int nblk = 2 * DFF / 32, kb = r / nblk, n0 = 32 * (r % nblk);
            const int pn = n0 >> 8, within = n0 & 255, src = (within >> 7) * DFF + 128 * pn + (within & 127);
            transpose_item(wfi, D, 2 * DFF, src, gffn, (bf16_t*)(ws + WS_WFI), n0, kb, scr, lane); continue; } r -= I_FI;
        transpose_item(wfd, DFF, D, 32 * (r % 32), nullptr, (bf16_t*)(ws + WS_WFD), 32 * (r % 32), r / 32, scr, lane);
    }
    const float* gm = p.in[2];
    bf16_t* XN = (bf16_t*)(ws + WS_XN);
    f32x4 gv[4];
#pragma unroll
    for (int j = 0; j < 4; ++j) gv[j] = *((const f32x4*)gm + lane + 64 * j);
    for (int row = 2 * gw; row < M; row += 2 * NGW) {
        const float* xrow = row < MP ? p.in[0] + (size_t)row * D : p.in[1] + (size_t)(row - MP) * D;
        const f32x4* xr = (const f32x4*)xrow + lane;
        f32x4 v[2][4]; float s0 = 0.f, s1 = 0.f;
#pragma unroll
        for (int j = 0; j < 4; ++j) { v[0][j] = xr[64 * j]; v[1][j] = xr[256 + 64 * j]; }
#pragma unroll
        for (int j = 0; j < 4; ++j) { s0 += (v[0][j][0] * v[0][j][0] + v[0][j][1] * v[0][j][1]) + (v[0][j][2] * v[0][j][2] + v[0][j][3] * v[0][j][3]);
                                      s1 += (v[1][j][0] * v[1][j][0] + v[1][j][1] * v[1][j][1]) + (v[1][j][2] * v[1][j][2] + v[1][j][3] * v[1][j][3]); }
        const float rs0 = 1.0f / sqrtf(wave_sum(s0) * (1.0f / D) + RMS_EPS), rs1 = 1.0f / sqrtf(wave_sum(s1) * (1.0f / D) + RMS_EPS);
        u32x2* o8 = (u32x2*)(XN + (size_t)row * D) + lane;
#pragma unroll
        for (int j = 0; j < 4; ++j) { const f32x4 y0 = v[0][j] * rs0 * gv[j], y1 = v[1][j] * rs1 * gv[j];
            u32x2 w0, w1; w0.x = pk2(y0[0], y0[1]); w0.y = pk2(y0[2], y0[3]); w1.x = pk2(y1[0], y1[1]); w1.y = pk2(y1[2], y1[3]);
            o8[64 * j] = w0; o8[256 + 64 * j] = w1; }
    }
}

constexpr int TAB_PAD = 64;
constexpr int AT_RING_OFF = 16384, AT_SLOT_K = 40 * 144, AT_SLOT_V = 64 * 80, AT_SLOT = AT_SLOT_K + AT_SLOT_V, AT_NSLOT = 11;
static_assert(AT_RING_OFF + AT_NSLOT * AT_SLOT <= 139264, "attention ring fits below the LDS control words");
struct AtStage { const bf16_t* Kb; const bf16_t* VT; int b, h, cbase; };
DI void at_chunk(const AtStage& st, int c, int a, const bf16_t*& g, unsigned& l) {
    const int rowi = c / 640, cc = c - rowi * 640, row = a + rowi, slot = row % AT_NSLOT;
    if (cc < 320) { const int col = cc >> 3, part = cc & 7;
        g = st.Kb + ((size_t)st.b * SEQ + row * 64 + st.cbase + col) * 512 + st.h * 64 + part * 8; l = AT_RING_OFF + slot * AT_SLOT + col * 144 + part * 16; }
    else { const int c2 = cc - 320, d = c2 / 5, part = c2 - d * 5;
        g = st.VT + ((size_t)(st.b * 8 + st.h) * 128 + row) * 4096 + d * 64 + st.cbase + part * 8; l = AT_RING_OFF + slot * AT_SLOT + AT_SLOT_K + d * 80 + part * 16; }
}
template <int NB> DI void at_issue(const AtStage& st, int tid, int a, int n, u32x4 (&buf)[NB]) {
    const int total = n * 640;
#pragma unroll
    for (int k = 0; k < NB; ++k) { const int c = tid + k * 512; if (c < total) { const bf16_t* g; unsigned l; at_chunk(st, c, a, g, l); buf[k] = *(const u32x4*)g; } }
}
template <int NB> DI void at_write(const AtStage& st, LAS unsigned char* lds, int tid, int a, int n, const u32x4 (&buf)[NB]) {
    const int total = n * 640;
#pragma unroll
    for (int k = 0; k < NB; ++k) { const int c = tid + k * 512; if (c < total) { const bf16_t* g; unsigned l; at_chunk(st, c, a, g, l); *(LAS u32x4*)(lds + l) = buf[k]; } }
}
DI int clamp_i(int v, int lo, int hi) { return v < lo ? lo : (v > hi ? hi : v); }
DI void p2_attention(const Params& p, LAS unsigned char* lds, int tid, int wave, int lane, int G, int bx) {
    unsigned char* ws = p.ws;
    const bf16_t* Q = (const bf16_t*)(ws + WS_Q);
    bf16_t* AC = (bf16_t*)(ws + WS_AC);
    const float* rpb = p.in[5];
    LAS float* tab = (LAS float*)lds + TAB_PAD;
    for (int i = tid; i < 8 * 15 * 32 + 2 * TAB_PAD; i += 512) { const int k = i - TAB_PAD; float v = 0.f;
        if (k >= 0 && k < 8 * 15 * 32) { const int h = k / 480, rem = k % 480, ri = rem >> 5, ci = rem & 31; if (ci < 31) v = rpb[(h * 15 + ri) * 31 + ci] * LOG2E; }
        ((LAS float*)lds)[i] = v; }
    __syncthreads();
    const int qi = lane & 15, mq = lane >> 4, jj = wave & 1, rr = wave >> 1;
    constexpr int NUNITS = 10 * 8 * 2 * 8;
    const int per = (NUNITS + G - 1) / G;
    for (int un = bx * per; un < (bx + 1) * per && un < NUNITS; ++un) {
        const int band = un & 7, ch = (un >> 3) & 1, bh = un >> 4, b = bh >> 3, h = bh & 7;
        const int j = 2 * ch + jj, cbase = ch ? 24 : 0, kcol0 = cbase + 8 * jj, qcol = 16 * j + qi;
        const int cstart = clamp_i(qcol - 8, 0, 48), t0 = kcol0 + 4 * mq - cstart, cidx0 = kcol0 + 4 * mq - qcol + 15;
        bool v0[4];
#pragma unroll
        for (int e = 0; e < 4; ++e) v0[e] = (t0 + e >= 0);
        AtStage st{(const bf16_t*)(ws + WS_K), (const bf16_t*)(ws + WS_VT), b, h, cbase};
        const int r0 = band * 16;
        int hi = clamp_i(r0 - 1, 0, 120) + 7;
        bf16x8 qf[2];
        { const int lo = clamp_i(r0 - 4, 0, 120);
          for (int a = lo; a <= hi; a += 4) { const int n = hi - a + 1 < 4 ? hi - a + 1 : 4;
              u32x4 buf[5]; at_issue<5>(st, tid, a, n, buf); at_write<5>(st, lds, tid, a, n, buf); }
          const size_t qtok = (size_t)b * SEQ + (r0 + rr) * 64 + qcol;
#pragma unroll
          for (int ks = 0; ks < 2; ++ks) qf[ks] = *(const bf16x8*)(Q + qtok * 512 + h * 64 + ks * 32 + mq * 8); }
        __syncthreads();
        for (int it = 0; it < 4; ++it) {
            const int r = r0 + 4 * it, q = r + rr;
            u32x4 pf[5]; bf16x8 qn[2]; int nhi = hi;
            if (it < 3) { nhi = clamp_i(r + 3, 0, 120) + 7;
                at_issue<5>(st, tid, hi + 1, nhi - hi, pf);
                const size_t qtn = (size_t)b * SEQ + (q + 4) * 64 + qcol;
#pragma unroll
                for (int ks = 0; ks < 2; ++ks) qn[ks] = *(const bf16x8*)(Q + qtn * 512 + h * 64 + ks * 32 + mq * 8); }
            __builtin_amdgcn_sched_barrier(0);
            const int rs = clamp_i(q - 4, 0, 120);
            const size_t qtok = (size_t)b * SEQ + q * 64 + qcol;
            f32x4 s[8][2];
            { int slot = rs % AT_NSLOT;
#pragma unroll
              for (int w = 0; w < 8; ++w) {
                const LAS unsigned char* kb = lds + AT_RING_OFF + slot * AT_SLOT + (8 * jj + qi) * 144 + mq * 16;
#pragma unroll
                for (int cb = 0; cb < 2; ++cb) {
                    const bf16x8 k0 = *(const LAS bf16x8*)(kb + cb * 16 * 144), k1 = *(const LAS bf16x8*)(kb + cb * 16 * 144 + 64);
                    f32x4 a = __builtin_amdgcn_mfma_f32_16x16x32_bf16(k0, qf[0], (f32x4){0.f, 0.f, 0.f, 0.f}, 0, 0, 0);
                    s[w][cb] = __builtin_amdgcn_mfma_f32_16x16x32_bf16(k1, qf[1], a, 0, 0, 0);
                }
                slot = slot + 1 == AT_NSLOT ? 0 : slot + 1;
              } }
            const LAS float* tb = tab + h * 480 + (rs - q + 7) * 32 + cidx0;
            float mx = -1e30f;
#pragma unroll
            for (int w = 0; w < 8; ++w)
#pragma unroll
                for (int cb = 0; cb < 2; ++cb)
#pragma unroll
                    for (int e = 0; e < 4; ++e) { const bool ok = cb == 0 ? v0[e] : !v0[e];
                        const float x = ok ? s[w][cb][e] + tb[32 * w + 16 * cb + e] : -1e30f; s[w][cb][e] = x; mx = fmaxf(mx, x); }
            mx = fmaxf(mx, __shfl_xor(mx, 16)); mx = fmaxf(mx, __shfl_xor(mx, 32));
            float sum = 0.f;
#pragma unroll
            for (int w = 0; w < 8; ++w)
#pragma unroll
                for (int cb = 0; cb < 2; ++cb)
#pragma unroll
                    for (int e = 0; e < 4; ++e) { const float pe = __builtin_amdgcn_exp2f(s[w][cb][e] - mx); s[w][cb][e] = pe; sum += pe; }
            sum += __shfl_xor(sum, 16); sum += __shfl_xor(sum, 32);
            const float inv = 1.0f / sum;
            f32x4 o[4];
#pragma unroll
            for (int db = 0; db < 4; ++db) o[db] = (f32x4){0.f, 0.f, 0.f, 0.f};
            { int slot = rs % AT_NSLOT;
#pragma unroll
              for (int w = 0; w < 8; ++w) {
                u32x4 pw; pw.x = pk2(s[w][0][0], s[w][0][1]); pw.y = pk2(s[w][0][2], s[w][0][3]); pw.z = pk2(s[w][1][0], s[w][1][1]); pw.w = pk2(s[w][1][2], s[w][1][3]);
                const bf16x8 pfr = __builtin_bit_cast(bf16x8, pw);
                const LAS unsigned char* vb = lds + AT_RING_OFF + slot * AT_SLOT + AT_SLOT_K + qi * 80 + (8 * jj + 4 * mq) * 2;
#pragma unroll
                for (int db = 0; db < 4; ++db) {
                    const u32x2 lo2 = *(const LAS u32x2*)(vb + db * 16 * 80), hi2 = *(const LAS u32x2*)(vb + db * 16 * 80 + 32);
                    u32x4 vw; vw.x = lo2.x; vw.y = lo2.y; vw.z = hi2.x; vw.w = hi2.y;
                    o[db] = __builtin_amdgcn_mfma_f32_16x16x32_bf16(__builtin_bit_cast(bf16x8, vw), pfr, o[db], 0, 0, 0);
                }
                slot = slot + 1 == AT_NSLOT ? 0 : slot + 1;
              } }
#pragma unroll
            for (int db = 0; db < 4; ++db) { const f32x4 y = o[db] * inv; u32x2 w2; w2.x = pk2(y[0], y[1]); w2.y = pk2(y[2], y[3]);
                *(u32x2*)(AC + qtok * 1024 + h * 64 + db * 16 + 4 * mq) = w2; }
            __syncthreads();
            if (it < 3) { at_write<5>(st, lds, tid, hi + 1, nhi - hi, pf); hi = nhi; qf[0] = qn[0]; qf[1] = qn[1]; }
            __syncthreads();
        }
    }
}
DI void p2_conv(const Params& p, int gtid, int nthreads) {
    unsigned char* ws = p.ws;
    const bf16_t* UBC = (const bf16_t*)(ws + WS_UBC); bf16_t* AC = (bf16_t*)(ws + WS_AC);
    const float* cw = p.in[6];
    const int c8 = (gtid & 63) * 8;
    float wt[3][8];
#pragma unroll
    for (int k = 0; k < 3; ++k) { const f32x4 a = *(const f32x4*)(cw + k * 512 + c8), b = *(const f32x4*)(cw + k * 512 + c8 + 4);
#pragma unroll
        for (int e = 0; e < 4; ++e) { wt[k][e] = a[e]; wt[k][4 + e] = b[e]; } }
    for (int idx = gtid; idx < (M / 4) * 64; idx += nthreads) {
        const int run = idx >> 6, tok0 = run * 4, t = tok0 & (SEQ - 1);
        const bf16_t* rp = UBC + (size_t)tok0 * 1536 + c8;
        const u32x4 zero = {0u, 0u, 0u, 0u};
        u32x4 uu[6], gg[6], bg[4];
#pragma unroll
        for (int i = 0; i < 6; ++i) { const bool ok = !((i == 0 && t == 0) || (i == 5 && t == SEQ - 4));
            uu[i] = ok ? *(const u32x4*)(rp + (ptrdiff_t)(i - 1) * 1536) : zero; gg[i] = ok ? *(const u32x4*)(rp + (ptrdiff_t)(i - 1) * 1536 + 1024) : zero; }
#pragma unroll
        for (int i = 0; i < 4; ++i) bg[i] = *(const u32x4*)(rp + (size_t)i * 1536 + 512);
        float z[6][8];
#pragma unroll
        for (int i = 0; i < 6; ++i)
#pragma unroll
            for (int e = 0; e < 4; ++e) { z[i][2 * e] = bf_lo(uu[i][e]) * bf_lo(gg[i][e]); z[i][2 * e + 1] = bf_hi(uu[i][e]) * bf_hi(gg[i][e]); }
#pragma unroll
        for (int i = 0; i < 4; ++i) { float o[8];
#pragma unroll
            for (int e = 0; e < 4; ++e) {
                o[2 * e]     = bf_lo(bg[i][e]) * (wt[0][2 * e] * z[i][2 * e] + wt[1][2 * e] * z[i + 1][2 * e] + wt[2][2 * e] * z[i + 2][2 * e]);
                o[2 * e + 1] = bf_hi(bg[i][e]) * (wt[0][2 * e + 1] * z[i][2 * e + 1] + wt[1][2 * e + 1] * z[i + 1][2 * e + 1] + wt[2][2 * e + 1] * z[i + 2][2 * e + 1]); }
            u32x4 w; w.x = pk2(o[0], o[1]); w.y = pk2(o[2], o[3]); w.z = pk2(o[4], o[5]); w.w = pk2(o[6], o[7]);
            *(u32x4*)(AC + (size_t)(tok0 + i) * 1024 + 512 + c8) = w; }
    }
}

DI void p7_final(const Params& p, int gw, int NGW, int lane) {
    const float* RSQ = (const float*)(p.ws + WS_RSQ2); const float* gf = p.in[13]; const bf16_t* XB = (const bf16_t*)(p.ws + WS_X1B);
    f32x4 gv[2][2];
#pragma unroll
    for (int hh = 0; hh < 2; ++hh) { gv[hh][0] = *(const f32x4*)(gf + hh * 512 + 8 * lane); gv[hh][1] = *(const f32x4*)(gf + hh * 512 + 8 * lane + 4); }
    for (int row = 2 * gw; row < M; row += 2 * NGW) {
        float s = lane < 32 ? RSQ[(size_t)row * 16 + lane] : 0.f;
#pragma unroll
        for (int o = 1; o < 16; o <<= 1) s += __shfl_xor(s, o);
        const float sa = __shfl(s, 0), sb = __shfl(s, 16);
        float rs[2]; rs[0] = 1.0f / sqrtf(sa * (1.0f / D) + RMS_EPS); rs[1] = 1.0f / sqrtf(sb * (1.0f / D) + RMS_EPS);
        u32x4 v[2][2];
#pragma unroll
        for (int rr = 0; rr < 2; ++rr)
#pragma unroll
            for (int hh = 0; hh < 2; ++hh) v[rr][hh] = *(const u32x4*)(XB + (size_t)(row + rr) * D + hh * 512 + 8 * lane);
#pragma unroll
        for (int rr = 0; rr < 2; ++rr)
#pragma unroll
            for (int hh = 0; hh < 2; ++hh) { const u32x4 w = v[rr][hh]; float* op = p.out + (size_t)(row + rr) * D + hh * 512 + 8 * lane;
                *(f32x4*)op = (f32x4){bf_lo(w.x), bf_hi(w.x), bf_lo(w.y), bf_hi(w.y)} * rs[rr] * gv[hh][0];
                *(f32x4*)(op + 4) = (f32x4){bf_lo(w.z), bf_hi(w.z), bf_lo(w.w), bf_hi(w.w)} * rs[rr] * gv[hh][1]; }
    }
}

#define XB_TMO      128
#define XB_XCNT(j)  (256  + 64 * (j))
#define XB_XSUB(j)  (1280 + 64 * (j))
#define XB_XGEN(j)  (2304 + 64 * (j))
#define XB_TOP      3328
#define XB_TOPGEN   3392
#define XCD_BAR_WORDS 3456
#define XB_SPIN_CAP (1u << 18)
DI unsigned xb_ld(unsigned* p)              { return __hip_atomic_load(p, __ATOMIC_RELAXED, __HIP_MEMORY_SCOPE_AGENT); }
DI unsigned xb_add(unsigned* p, unsigned v) { return __hip_atomic_fetch_add(p, v, __ATOMIC_RELAXED, __HIP_MEMORY_SCOPE_AGENT); }
DI unsigned xb_xcc_id() { return (unsigned)__builtin_amdgcn_s_getreg((3 << 11) | 20) & 0xFu; }
#define XB_SPIN(cond, bar) do { unsigned _sp = 0; while (cond) { __builtin_amdgcn_s_sleep(1); \
    if ((++_sp & 255u) == 0u) { if (xb_ld(&(bar)[XB_TMO])) break; if (_sp > XB_SPIN_CAP) { atomicAdd(&(bar)[XB_TMO], 1u); break; } } } } while (0)
struct XcdBarrier { unsigned* bar; unsigned x; volatile LAS unsigned* st; };
DI XcdBarrier xcd_barrier_post(unsigned* bar, volatile LAS unsigned* st) {
    XcdBarrier b; b.bar = bar; b.x = xb_xcc_id(); b.st = st;
    if (threadIdx.x == 0) (void)xb_add(&bar[XB_XCNT(b.x)], 1u);
    return b;
}
DI void xcd_barrier_complete(unsigned* bar, unsigned x, unsigned& nloc, unsigned& nx) {
    const unsigned G = gridDim.x * gridDim.y * gridDim.z;
    unsigned sum, cnt, mine, sp = 0u;
    for (;;) {
        sum = 0u; cnt = 0u; mine = 0u;
#pragma unroll
        for (unsigned j = 0; j < 16; ++j) { const unsigned c = xb_ld(&bar[XB_XCNT(j)]); sum += c; cnt += (c > 0u) ? 1u : 0u; mine = (j == x) ? c : mine; }
        if (sum == G) break;
        __builtin_amdgcn_s_sleep(1);
        if ((++sp & 255u) == 0u) { if (xb_ld(&bar[XB_TMO])) break; if (sp > XB_SPIN_CAP) { atomicAdd(&bar[XB_TMO], 1u); break; } }
    }
    nloc = mine > 0u ? mine : 1u; nx = cnt > 0u ? cnt : 1u;
}
DI void xcd_barrier(const XcdBarrier& b) {
    asm volatile("s_waitcnt vmcnt(0)" ::: "memory");
    __syncthreads();
    if (threadIdx.x == 0) {
        unsigned* bar = b.bar;
        __builtin_amdgcn_s_waitcnt(0);
        unsigned nloc = b.st[0], nx = b.st[1];
        if (nloc == 0u) { xcd_barrier_complete(bar, b.x, nloc, nx); b.st[0] = nloc; b.st[1] = nx; }
        const unsigned old = xb_add(&bar[XB_XSUB(b.x)], 1u);
        const unsigned gen = old / nloc;
        if (old + 1u == (gen + 1u) * nloc) {
            __builtin_amdgcn_fence(__ATOMIC_RELEASE, "agent");
            asm volatile("s_waitcnt vmcnt(0)" ::: "memory");
            const unsigned og = xb_add(&bar[XB_TOP], 1u);
            const unsigned tg = og / nx;
            if (og + 1u == (tg + 1u) * nx) xb_add(&bar[XB_TOPGEN], 1u);
            else XB_SPIN(xb_ld(&bar[XB_TOPGEN]) == tg, bar);
            __builtin_amdgcn_fence(__ATOMIC_ACQUIRE, "agent");
            xb_add(&bar[XB_XGEN(b.x)], 1u);
            asm volatile("s_waitcnt vmcnt(0)" ::: "memory");
        } else {
            XB_SPIN(xb_ld(&bar[XB_XGEN(b.x)]) == gen, bar);
            __builtin_amdgcn_fence(__ATOMIC_ACQUIRE, "agent");
            asm volatile("s_waitcnt vmcnt(0)" ::: "memory");
        }
    }
    __syncthreads();
}

__global__ void __launch_bounds__(512, 2) fwd_megakernel(Params p) {
    extern __shared__ __attribute__((aligned(16))) unsigned char lds_raw[];
    LAS unsigned char* lds = (LAS unsigned char*)lds_raw;
    cg::grid_group grid = cg::this_grid();
    const int tid = threadIdx.x, lane = tid & 63, wave = __builtin_amdgcn_readfirstlane(tid >> 6);
    const int G = gridDim.x, bx = blockIdx.x;
    const int gw = bx * 8 + wave, NGW = G * 8;
    unsigned char* ws = p.ws;
    const int lo = p.ph_lo, hi = p.ph_hi;
#define IN(k) (lo <= (k) && (k) < hi)
#define SEAM(k) do { if (IN(k) && IN((k) + 1)) xcd_barrier(xbar); } while (0)
    volatile LAS unsigned* misc = (volatile LAS unsigned*)(lds + MISC_OFF);
    if (tid < 16) misc[tid] = 0u;
    __syncthreads();
    const XcdBarrier xbar = xcd_barrier_post((unsigned*)ws, misc + 8);
    bf16_t* XN = (bf16_t*)(ws + WS_XN); bf16_t* Wt_in = (bf16_t*)(ws + WS_WIN);

    if (IN(0)) { p0_prologue(p, lds, gw, NGW, wave, lane); }
    SEAM(0);
    if (IN(1)) {
        pg8::Gemm g{XN, Wt_in, M, NMAIN, D, D};
        pg8::DualOrder S; S.s0.init(M, NMAIN, G, bx); S.s1.init(DA, M, G, bx); S.A1 = Wt_in + (size_t)NMAIN * D; S.Bt1 = XN;
        EpiP1 E{EpiProj{(bf16_t*)(ws + WS_Q), (bf16_t*)(ws + WS_K), (bf16_t*)(ws + WS_UBC), (bf16_t*)(ws + WS_G), p.in[4]}, EpiVT{(bf16_t*)(ws + WS_VT)}};
        pg8::gemm_phase<EpiP1, pg8::DualOrder, true>(lds, g, S, E);
    }
    SEAM(1);
    if (IN(2)) { p2_conv(p, bx * 512 + tid, G * 512); p2_attention(p, lds, tid, wave, lane, G, bx); __syncthreads(); }
    SEAM(2);
    if (IN(3)) {
        pg8::Gemm g{(bf16_t*)(ws + WS_AC), (bf16_t*)(ws + WS_WA), M, D, D, D}; pg8::StaticOrder S; S.init(M, D, G, bx);
        EpiMerge E{(bf16_t*)(ws + WS_MG), (const unsigned char*)(ws + WS_G)};
        pg8::gemm_phase<EpiMerge, pg8::StaticOrder, true>(lds, g, S, E);
    }
    SEAM(3);
    if (IN(4)) {
        pg8::Gemm g{(bf16_t*)(ws + WS_MG), (bf16_t*)(ws + WS_WOUT), M, D, D, D}; pg8::StaticOrder S; S.init(M, D, G, bx);
        EpiResid E{p.in[0], p.in[1], (bf16_t*)(ws + WS_X1B), (float*)(ws + WS_RSQ1), 0};
        pg8::gemm_phase<EpiResid, pg8::StaticOrder, true>(lds, g, S, E);
    }
    SEAM(4);
    if (IN(5)) {
        pg8::Gemm g{(bf16_t*)(ws + WS_X1B), (bf16_t*)(ws + WS_WFI), M, 2 * DFF, D, D}; pg8::StaticOrder S; S.init(M, 2 * DFF, G, bx);
        EpiFfnIn E{(bf16_t*)(ws + WS_ACT), (const float*)(ws + WS_RSQ1)};
        pg8::gemm_phase<EpiFfnIn, pg8::StaticOrder, true>(lds, g, S, E);
    }
    SEAM(5);
    if (IN(6)) {
        pg8::Gemm g{(bf16_t*)(ws + WS_ACT), (bf16_t*)(ws + WS_WFD), M, D, DFF, DFF}; pg8::StaticOrder S; S.init(M, D, G, bx);
        EpiResid E{nullptr, nullptr, (bf16_t*)(ws + WS_X1B), (float*)(ws + WS_RSQ2), 1};
        pg8::gemm_phase<EpiResid, pg8::StaticOrder, true>(lds, g, S, E);
    }
    SEAM(6);
    if (IN(7)) { p7_final(p, gw, NGW, lane); }
    if (p.ph_hi > 1000) grid.sync();
#undef IN
#undef SEAM
}

extern "C" void kernel_launch(void* const* d_in, const int* in_sizes, int n_in, void* d_out, int out_size, void* d_ws, size_t ws_size, hipStream_t stream) {
    static int grid_blocks = 0;
    if (grid_blocks == 0) {
        if (n_in != 14 || in_sizes[0] != MP * D || in_sizes[1] != (M - MP) * D || out_size != M * D || ws_size < WS_END) {
            fprintf(stderr, "kernel_launch: unexpected shapes / workspace (n_in %d, ws %zu); nothing launched\n", n_in, ws_size); grid_blocks = -1; return; }
        int dev = 0, cus = 0, per_cu = 0;
        (void)hipGetDevice(&dev);
        (void)hipDeviceGetAttribute(&cus, hipDeviceAttributeMultiprocessorCount, dev);
        (void)hipFuncSetAttribute((const void*)fwd_megakernel, hipFuncAttributeMaxDynamicSharedMemorySize, LDS_BYTES);
        (void)hipOccupancyMaxActiveBlocksPerMultiprocessor(&per_cu, (const void*)fwd_megakernel, 512, LDS_BYTES);
        (void)hipGetLastError();
        if (per_cu < 1) per_cu = 1;
        grid_blocks = cus * per_cu;
    }
    if (grid_blocks < 0) return;
    if (hipMemsetAsync(d_ws, 0, 16384, stream) != hipSuccess) { fprintf(stderr, "kernel_launch: memset of the barrier words failed\n"); return; }
    Params p{};
    for (int i = 0; i < 14; ++i) p.in[i] = (const float*)d_in[i];
    p.out = (float*)d_out; p.ws = (unsigned char*)d_ws; p.ph_lo = 0; p.ph_hi = 8;
    void* args[] = {&p};
    hipError_t e = hipLaunchCooperativeKernel((const void*)fwd_megakernel, dim3(grid_blocks), dim3(512), args, LDS_BYTES, stream);
    if (e != hipSuccess) fprintf(stderr, "cooperative launch failed: %s (grid %d)\n", hipGetErrorString(e), grid_blocks);
}
```

```cpp
#include <hip/hip_runtime.h>
#include <hip/hip_cooperative_groups.h>
#include <cstdio>
#include <cstdint>
namespace cg = cooperative_groups;

#define DI __device__ __forceinline__
#define LAS __attribute__((address_space(3)))
typedef unsigned short bf16_t;
typedef short bf16x8 __attribute__((ext_vector_type(8)));
typedef short s16x4 __attribute__((ext_vector_type(4)));
typedef float f32x4 __attribute__((ext_vector_type(4)));
typedef float f32x2 __attribute__((ext_vector_type(2)));
typedef unsigned u32x4 __attribute__((ext_vector_type(4)));
typedef unsigned u32x2 __attribute__((ext_vector_type(2)));
typedef __bf16 bf16x2n __attribute__((ext_vector_type(2)));

constexpr int M = 81920, MP = 65536, D = 1024, DA = 512, DFF = 2816, SEQ = 8192;
constexpr int NIN = 5120, NMAIN = 4608;
constexpr float RMS_EPS = 1e-6f, LOG2E = 1.4426950408889634f;
constexpr float QSCALE = 0.125f * LOG2E;
constexpr size_t MiB = 1u << 20;
constexpr size_t WS_WIN = 1 * MiB, WS_WA = 11 * MiB, WS_WC = 12 * MiB, WS_WOUT = 13 * MiB, WS_WFI = 15 * MiB, WS_WFD = 26 * MiB;
constexpr size_t WS_RSQ1 = 32 * MiB, WS_RSQ2 = 38 * MiB;
constexpr size_t WS_G = 44 * MiB, WS_Q = 364 * MiB, WS_K = 444 * MiB, WS_VT = 524 * MiB, WS_UBC = 604 * MiB, WS_XN = 844 * MiB;
constexpr size_t WS_AC = WS_G + 160 * MiB, WS_MG = WS_Q, WS_X1B = WS_VT, WS_ACT = WS_G, WS_RSX = 43 * MiB, WS_END = 1004 * MiB;
constexpr int LDS_BYTES = 147456, MISC_OFF = 143360;

DI unsigned pk2(float lo, float hi) { f32x2 v = {lo, hi}; return __builtin_bit_cast(unsigned, __builtin_convertvector(v, bf16x2n)); }
DI float bf_lo(unsigned w) { return __uint_as_float(w << 16); }
DI float bf_hi(unsigned w) { return __uint_as_float(w & 0xffff0000u); }
DI float fast_sigmoid(float v) { return __builtin_amdgcn_rcpf(1.0f + __builtin_amdgcn_exp2f(-v * LOG2E)); }

namespace pg8 {
constexpr int BM = 256, BK = 64, HALF = 128, HTB = HALF * BK * 2, STAGE_BYTES = 8 * HTB, NXCD = 8, WGM = 8;
DI int lds_byte(int r, int c) { const int st = (r >> 4) * 2 + (c >> 5), rr = r & 15, cc = c & 31, ob = rr * 64 + cc * 2; return st * 1024 + (ob ^ (((ob >> 9) & 1) << 5)); }
DI void stage_rc(int b, int& R, int& C) { const int st = b / 1024, sb = b % 1024, swz = sb ^ (((sb >> 9) & 1) << 5); R = (st >> 1) * 16 + swz / 64; C = (st & 1) * 32 + (swz % 64) / 2; }
DI int perm32(int rho) { const int n = rho >> 4, i = rho & 15; return 8 * (i >> 2) + 4 * n + (i & 3); }

struct Unit { int pm, pn, kind; };
struct Gemm { const bf16_t* A; const bf16_t* Bt; int M, N, K, lda; };

struct StaticOrder {
    int nM, nN, nwg, G, c;
    DI void init(int M_, int N_, int G_, int c_) { nM = M_ / BM; nN = N_ / BM; nwg = nM * nN; G = G_; c = c_; }
    DI bool next(int i, Unit& u) const {
        const long L = (long)i * G + c; if (L >= nwg) return false;
        int wgid = (int)L; { const int q = nwg / NXCD, r = nwg % NXCD, xcd = wgid % NXCD, off = wgid / NXCD; wgid = (xcd < r ? xcd * (q + 1) : r * (q + 1) + (xcd - r) * q) + off; }
        const int nig = WGM * nN, gid = wgid / nig, fm = gid * WGM, gsz = (nM - fm) < WGM ? (nM - fm) : WGM;
        u.pm = fm + ((wgid % nig) % gsz); u.pn = (wgid % nig) / gsz; u.kind = 0; return true;
    }
    DI const char* a_ptr(const Gemm& g, const Unit& u, size_t tstepA) const { return (const char*)g.A + (size_t)u.pm * tstepA; }
    DI const char* b_ptr(const Gemm& g, const Unit& u, size_t tstepB) const { return (const char*)g.Bt + (size_t)u.pn * tstepB; }
};
struct VtOrder {
    int G, c;
    DI bool next(int i, Unit& u) const {
        int L;
        if (G == 256) { if (c >= 128) { if (i >= 3) return false; L = (c - 128) + 128 * i; } else { if (i >= 2) return false; L = 384 + c + 128 * i; } }
        else { L = i * G + c; if (L >= 640) return false; }
        u.pn = L >> 1; u.pm = L & 1; u.kind = 1; return true;
    }
    DI const char* a_ptr(const Gemm& g, const Unit& u, size_t tstepA) const { return (const char*)g.A + (size_t)u.pm * tstepA; }
    DI const char* b_ptr(const Gemm& g, const Unit& u, size_t tstepB) const { return (const char*)g.Bt + (size_t)u.pn * tstepB; }
};
struct DualOrder {
    StaticOrder s0, s1; const bf16_t* A1; const bf16_t* Bt1;
    DI bool next(int i, Unit& u) const {
        const long L = (long)i * s0.G + s0.c;
        if (L < s0.nwg) return s0.next(i, u);
        const long L1 = L - s0.nwg; if (L1 >= s1.nwg) return false;
        StaticOrder t = s1; t.c = (int)(L1 % s1.G); const bool ok = t.next((int)(L1 / s1.G), u); u.kind = 1; return ok;
    }
    DI const char* a_ptr(const Gemm& g, const Unit& u, size_t tstepA) const { return (const char*)(u.kind ? A1 : g.A) + (size_t)u.pm * tstepA; }
    DI const char* b_ptr(const Gemm& g, const Unit& u, size_t tstepB) const { return (const char*)(u.kind ? Bt1 : g.Bt) + (size_t)u.pn * tstepB; }
};

template <class Epi, class Sched, bool ALIGN_EPI>
DI void gemm_phase(LAS unsigned char* lds, const Gemm g, const Sched& S, const Epi& E) {
    const int tid = threadIdx.x, wid = __builtin_amdgcn_readfirstlane(tid >> 6), lane = tid & 63, wr = wid >> 2, wc = wid & 3, fr = lane & 15, fq = lane >> 4;
    const int K = g.K, nt = K / BK, lda = g.lda;
    unsigned voffA[2], voffB[2];
#pragma unroll
    for (int i = 0; i < 2; ++i) { int R, C; stage_rc(tid * 16 + i * 8192, R, C); const int Rb = Epi::PERM ? ((R & ~31) + perm32(R & 31)) : R;
        voffA[i] = (unsigned)(R * lda + C) * 2u; voffB[i] = (unsigned)(Rb * K + C) * 2u; }
    const size_t kstep = (size_t)(BK * 2);
    const size_t hstepA = (size_t)HALF * lda * 2, hstepB = (size_t)HALF * K * 2;
    const size_t tstepA = 2 * hstepA, tstepB = 2 * hstepB;
    const unsigned ldsw = (unsigned)wid * 1024u;
    const int aoff = lds_byte(wr * 64 + fr, fq * 8), boff = lds_byte(wc * 32 + fr, fq * 8);
#define PG8_SA(b, h) (((b) * 2 + (h)) * HTB)
#define PG8_SB(b, h) ((4 + (b) * 2 + (h)) * HTB)
#define PG8_STAGE(bufoff, gbase, voff) do { _Pragma("unroll") for (int _i = 0; _i < 2; ++_i) \
        __builtin_amdgcn_global_load_lds((const unsigned*)((const char*)(gbase) + (voff)[_i]), (LAS unsigned*)(lds + (bufoff) + ldsw + _i * 8192), 16, 0, 0); } while (0)
#define PG8_LDA(dst, b, h) do { _Pragma("unroll") for (int m = 0; m < 4; ++m) _Pragma("unroll") for (int k = 0; k < 2; ++k) dst[m][k] = *(const LAS bf16x8*)(lds + PG8_SA(b, h) + aoff + m * 2048 + k * 1024); } while (0)
#define PG8_LDB(dst, b, h) do { _Pragma("unroll") for (int n = 0; n < 2; ++n) _Pragma("unroll") for (int k = 0; k < 2; ++k) dst[n][k] = *(const LAS bf16x8*)(lds + PG8_SB(b, h) + boff + n * 2048 + k * 1024); } while (0)
#define PG8_MMA(ai, bj, At, Bt) do { __builtin_amdgcn_s_setprio(1); _Pragma("unroll") for (int m = 0; m < 4; ++m) _Pragma("unroll") for (int n = 0; n < 2; ++n) _Pragma("unroll") for (int k = 0; k < 2; ++k) \
        acc[ai][bj][m][n] = __builtin_amdgcn_mfma_f32_16x16x32_bf16(Bt[n][k], At[m][k], acc[ai][bj][m][n], 0, 0, 0); __builtin_amdgcn_s_setprio(0); } while (0)
#define PG8_WAIT_V(n) asm volatile("s_waitcnt vmcnt(" #n ")" ::: "memory")
#define PG8_WAIT_L(n) asm volatile("s_waitcnt lgkmcnt(" #n ")" ::: "memory")
#define PG8_BAR __builtin_amdgcn_s_barrier()
#define PG8_SCHED __builtin_amdgcn_sched_barrier(0)
    Unit cur, nxt; int ui = 0;
    if (!S.next(0, cur)) return;
    f32x4 acc[2][2][4][2];
#pragma unroll
    for (int a = 0; a < 2; ++a)
#pragma unroll
        for (int b = 0; b < 2; ++b)
#pragma unroll
            for (int m = 0; m < 4; ++m)
#pragma unroll
                for (int n = 0; n < 2; ++n) acc[a][b][m][n] = (f32x4){0.f, 0.f, 0.f, 0.f};
    bf16x8 At[4][2], B0[2][2], B1[2][2];
    const char* cA = S.a_ptr(g, cur, tstepA); const char* cB = S.b_ptr(g, cur, tstepB);
    PG8_STAGE(PG8_SB(0, 0), cB, voffB); PG8_STAGE(PG8_SB(0, 1), cB + hstepB, voffB); PG8_STAGE(PG8_SA(0, 0), cA, voffA); PG8_STAGE(PG8_SA(0, 1), cA + hstepA, voffA);
    if (wr == 1) PG8_BAR;
    PG8_WAIT_V(2); PG8_BAR;
    PG8_STAGE(PG8_SB(1, 0), cB + kstep, voffB); PG8_STAGE(PG8_SA(1, 0), cA + kstep, voffA); PG8_STAGE(PG8_SB(1, 1), cB + hstepB + kstep, voffB);
    PG8_WAIT_V(6); PG8_BAR;
    for (;;) {
        const bool has_next = S.next(ui + 1, nxt);
        const char* nA = has_next ? S.a_ptr(g, nxt, tstepA) : cA; const char* nB = has_next ? S.b_ptr(g, nxt, tstepB) : cB;
        for (int t = 0; t < nt; t += 2) {
            const bool last = (t == nt - 2);
            const char* a1 = cA + (size_t)(t + 1) * kstep;
            const char* a2 = last ? nA : cA + (size_t)(t + 2) * kstep; const char* b2 = last ? nB : cB + (size_t)(t + 2) * kstep;
            const char* a3 = a2 + kstep; const char* b3 = b2 + kstep;
            if constexpr (Epi::MID) { if (t == (nt >> 1)) E.mid(acc, cur, wr, wc, fr, fq); }
            PG8_LDB(B0, 0, 0); PG8_LDB(B1, 0, 1); PG8_SCHED; PG8_LDA(At, 0, 0); PG8_STAGE(PG8_SA(1, 1), a1 + hstepA, voffA);
            PG8_WAIT_V(8); PG8_WAIT_L(0); PG8_BAR; PG8_MMA(0, 0, At, B0); PG8_MMA(0, 1, At, B1); PG8_BAR; PG8_SCHED;
            PG8_LDA(At, 0, 1); PG8_STAGE(PG8_SB(0, 0), b2, voffB); PG8_STAGE(PG8_SB(0, 1), b2 + hstepB, voffB); PG8_STAGE(PG8_SA(0, 0), a2, voffA);
            PG8_WAIT_V(8); PG8_WAIT_L(0); PG8_BAR; PG8_MMA(1, 0, At, B0); PG8_MMA(1, 1, At, B1); PG8_BAR; PG8_SCHED;
            PG8_LDB(B0, 1, 0); PG8_LDB(B1, 1, 1); PG8_SCHED; PG8_LDA(At, 1, 0); PG8_STAGE(PG8_SA(0, 1), a2 + hstepA, voffA);
            PG8_WAIT_V(8); PG8_WAIT_L(0); PG8_BAR; PG8_MMA(0, 0, At, B0); PG8_MMA(0, 1, At, B1); PG8_BAR; PG8_SCHED;
            PG8_LDA(At, 1, 1); PG8_STAGE(PG8_SB(1, 0), b3, voffB); PG8_STAGE(PG8_SB(1, 1), b3 + hstepB, voffB); PG8_STAGE(PG8_SA(1, 0), a3, voffA);
            PG8_WAIT_V(8); PG8_WAIT_L(0); PG8_BAR; PG8_MMA(1, 0, At, B0); PG8_MMA(1, 1, At, B1); PG8_BAR; PG8_SCHED;
        }
        if constexpr (ALIGN_EPI) { if (wr == 0) PG8_BAR; }
        E(acc, cur, wr, wc, fr, fq);
        if (!has_next) break;
#pragma unroll
        for (int a = 0; a < 2; ++a)
#pragma unroll
            for (int b = 0; b < 2; ++b)
#pragma unroll
                for (int m = 0; m < 4; ++m)
#pragma unroll
                    for (int n = 0; n < 2; ++n) acc[a][b][m][n] = (f32x4){0.f, 0.f, 0.f, 0.f};
        cur = nxt; cA = nA; cB = nB; ++ui;
        if constexpr (ALIGN_EPI) { if (wr == 1) PG8_BAR; }
    }
    PG8_WAIT_V(0);
    if constexpr (!ALIGN_EPI) { if (wr == 0) PG8_BAR; }
    PG8_BAR;
#undef PG8_SA
#undef PG8_SB
#undef PG8_STAGE
#undef PG8_LDA
#undef PG8_LDB
#undef PG8_MMA
#undef PG8_WAIT_V
#undef PG8_WAIT_L
#undef PG8_BAR
#undef PG8_SCHED
}
}
using pg8::Unit;

struct EpiProj {
    static constexpr bool MID = false;
    static constexpr bool PERM = true;
    bf16_t *Q, *K, *UBC, *G; const float* bgate;
    DI void operator()(const f32x4 (&acc)[2][2][4][2], const Unit& u, int wr, int wc, int fr, int fq) const {
        const int row0 = u.pm * 256 + wr * 64 + fr, cl = wc * 32 + 8 * fq, pn = u.pn;
        bf16_t* base; int ld; float sc = 1.f; bool gate = false; int gcol = 0;
        if (pn < 2) { base = Q + pn * 256; ld = 512; sc = QSCALE; }
        else if (pn < 4) { base = K + (pn - 2) * 256; ld = 512; }
        else if (pn < 10) { base = UBC + (pn - 4) * 256; ld = 1536; }
        else { base = G; ld = 0; gate = true; gcol = (pn - 10) * 256; }
        f32x4 bv[2][2];
#pragma unroll
        for (int bj = 0; bj < 2; ++bj)
#pragma unroll
            for (int n = 0; n < 2; ++n) bv[bj][n] = gate ? *(const f32x4*)(bgate + gcol + cl + bj * 128 + 4 * n) : (f32x4){0.f, 0.f, 0.f, 0.f};
#pragma unroll
        for (int ai = 0; ai < 2; ++ai)
#pragma unroll
            for (int m = 0; m < 4; ++m) { bf16_t* rowp = base + (size_t)(row0 + ai * 128 + m * 16) * ld + cl;
#pragma unroll
                for (int bj = 0; bj < 2; ++bj) { f32x4 v0 = acc[ai][bj][m][0] + bv[bj][0], v1 = acc[ai][bj][m][1] + bv[bj][1];
                    if (gate) {
                        unsigned q0[4], q1[4];
#pragma unroll
                        for (int e = 0; e < 4; ++e) { q0[e] = (unsigned)fmaxf(fast_sigmoid(v0[e]) * 255.0f + 0.5f, 1.0f); q1[e] = (unsigned)fmaxf(fast_sigmoid(v1[e]) * 255.0f + 0.5f, 1.0f); }
                        u32x2 w; w.x = q0[0] | (q0[1] << 8) | (q0[2] << 16) | (q0[3] << 24); w.y = q1[0] | (q1[1] << 8) | (q1[2] << 16) | (q1[3] << 24);
                        *(u32x2*)((unsigned char*)G + (size_t)(row0 + ai * 128 + m * 16) * 2048 + gcol + cl + bj * 128) = w;
                    } else { v0 = v0 * sc; v1 = v1 * sc;
                        u32x4 w; w.x = pk2(v0[0], v0[1]); w.y = pk2(v0[2], v0[3]); w.z = pk2(v1[0], v1[1]); w.w = pk2(v1[2], v1[3]);
                        *(u32x4*)(rowp + bj * 128) = w; } } }
    }
};
struct EpiVT {
    static constexpr bool MID = false;
    static constexpr bool PERM = true;
    bf16_t* VT;
    DI void operator()(const f32x4 (&acc)[2][2][4][2], const Unit& u, int wr, int wc, int fr, int fq) const {
        const int ch0 = u.pm * 256 + wr * 64 + fr, tokl = u.pn * 256 + wc * 32 + 8 * fq;
#pragma unroll
        for (int ai = 0; ai < 2; ++ai)
#pragma unroll
            for (int m = 0; m < 4; ++m) { const int ch = ch0 + ai * 128 + m * 16, h = ch >> 6, d = ch & 63;
#pragma unroll
                for (int bj = 0; bj < 2; ++bj) { const int tok = tokl + bj * 128, b = tok >> 13, t = tok & 8191, row = t >> 6, col = t & 63;
                    const f32x4 v0 = acc[ai][bj][m][0], v1 = acc[ai][bj][m][1];
                    u32x4 w; w.x = pk2(v0[0], v0[1]); w.y = pk2(v0[2], v0[3]); w.z = pk2(v1[0], v1[1]); w.w = pk2(v1[2], v1[3]);
                    *(u32x4*)(VT + ((((size_t)(b * 8 + h) * 128 + row) * 64 + d) * 64 + col)) = w; } }
    }
};
struct EpiP1 {
    static constexpr bool PERM = true, MID = false;
    EpiProj ep; EpiVT ev;
    DI void operator()(const f32x4 (&acc)[2][2][4][2], const Unit& u, int wr, int wc, int fr, int fq) const { if (u.kind) ev(acc, u, wr, wc, fr, fq); else ep(acc, u, wr, wc, fr, fq); }
};
struct EpiMerge {
    static constexpr bool PERM = true, MID = true;
    bf16_t* MG; const unsigned char* G;
    DI void mid(f32x4 (&acc)[2][2][4][2], const Unit& u, int wr, int wc, int fr, int fq) const {
        int row0 = u.pm * 256 + wr * 64 + fr, c0 = u.pn * 256 + wc * 32 + 8 * fq;
        asm volatile("" : "+v"(row0), "+v"(c0));
#pragma unroll
        for (int ai = 0; ai < 2; ++ai) {
            u32x2 ga[4][2], gc[4][2];
#pragma unroll
            for (int m = 0; m < 4; ++m)
#pragma unroll
                for (int bj = 0; bj < 2; ++bj) { const unsigned char* gp = G + (size_t)(row0 + ai * 128 + m * 16) * 2048 + c0 + bj * 128;
                    ga[m][bj] = *(const u32x2*)gp; gc[m][bj] = *(const u32x2*)(gp + 1024); }
#pragma unroll
            for (int m = 0; m < 4; ++m)
#pragma unroll
                for (int bj = 0; bj < 2; ++bj) { const u32x2 a = ga[m][bj], c = gc[m][bj];
#pragma unroll
                    for (int e = 0; e < 4; ++e) {
                        acc[ai][bj][m][0][e] *= (float)((a.x >> (8 * e)) & 0xffu) * __builtin_amdgcn_rcpf((float)((c.x >> (8 * e)) & 0xffu));
                        acc[ai][bj][m][1][e] *= (float)((a.y >> (8 * e)) & 0xffu) * __builtin_amdgcn_rcpf((float)((c.y >> (8 * e)) & 0xffu)); } }
            asm volatile("" ::: "memory");
        }
    }
    DI void operator()(const f32x4 (&acc)[2][2][4][2], const Unit& u, int wr, int wc, int fr, int fq) const {
        const int row0 = u.pm * 256 + wr * 64 + fr, c0 = u.pn * 256 + wc * 32 + 8 * fq;
        constexpr float I255 = 1.0f / 255.0f;
        u32x2 gc[2][4][2];
#pragma unroll
        for (int ai = 0; ai < 2; ++ai)
#pragma unroll
            for (int m = 0; m < 4; ++m)
#pragma unroll
                for (int bj = 0; bj < 2; ++bj) gc[ai][m][bj] = *(const u32x2*)(G + (size_t)(row0 + ai * 128 + m * 16) * 2048 + 1024 + c0 + bj * 128);
#pragma unroll
        for (int ai = 0; ai < 2; ++ai)
#pragma unroll
            for (int m = 0; m < 4; ++m)
#pragma unroll
                for (int bj = 0; bj < 2; ++bj) { const u32x2 c = gc[ai][m][bj];
                    f32x4 v0 = acc[ai][bj][m][0], v1 = acc[ai][bj][m][1];
#pragma unroll
                    for (int e = 0; e < 4; ++e) { v0[e] *= (float)((c.x >> (8 * e)) & 0xffu) * I255; v1[e] *= (float)((c.y >> (8 * e)) & 0xffu) * I255; }
                    u32x4 w; w.x = pk2(v0[0], v0[1]); w.y = pk2(v0[2], v0[3]); w.z = pk2(v1[0], v1[1]); w.w = pk2(v1[2], v1[3]);
                    *(u32x4*)(MG + (size_t)(row0 + ai * 128 + m * 16) * 1024 + c0 + bj * 128) = w; }
    }
};
struct EpiResid {
    static constexpr bool MID = false;
    static constexpr bool PERM = false;
    const bf16_t* XN; const float* RSX; const float* IG; bf16_t* XB; float* RSQ; int inplace;
    DI void operator()(const f32x4 (&acc)[2][2][4][2], const Unit& u, int wr, int wc, int fr, int fq) const {
        const int row0 = u.pm * 256 + wr * 64 + fr, c0 = u.pn * 256 + wc * 32 + 4 * fq;
#pragma unroll
        for (int ai = 0; ai < 2; ++ai) {
            f32x4 xv[4][2][2];
            if (inplace) {
#pragma unroll
                for (int m = 0; m < 4; ++m) { const bf16_t* bp = XB + (size_t)(row0 + ai * 128 + m * 16) * 1024 + c0;
#pragma unroll
                    for (int bj = 0; bj < 2; ++bj)
#pragma unroll
                        for (int n = 0; n < 2; ++n) { const u32x2 w = *(const u32x2*)(bp + bj * 128 + n * 16); xv[m][bj][n] = (f32x4){bf_lo(w.x), bf_hi(w.x), bf_lo(w.y), bf_hi(w.y)}; } }
            } else {
#pragma unroll
                for (int m = 0; m < 4; ++m) { const int row = row0 + ai * 128 + m * 16; const bf16_t* bp = XN + (size_t)row * 1024 + c0; const float ir = 1.0f / RSX[row];
#pragma unroll
                    for (int bj = 0; bj < 2; ++bj)
#pragma unroll
                        for (int n = 0; n < 2; ++n) { const u32x2 w = *(const u32x2*)(bp + bj * 128 + n * 16); const f32x4 ig = *(const f32x4*)(IG + c0 + bj * 128 + n * 16);
                            xv[m][bj][n] = (f32x4){bf_lo(w.x), bf_hi(w.x), bf_lo(w.y), bf_hi(w.y)} * ir * ig; } }
            }
#pragma unroll
            for (int m = 0; m < 4; ++m) { const int row = row0 + ai * 128 + m * 16;
                float ss = 0.f;
#pragma unroll
                for (int bj = 0; bj < 2; ++bj)
#pragma unroll
                    for (int n = 0; n < 2; ++n) { const int c = c0 + bj * 128 + n * 16;
                        const f32x4 o = xv[m][bj][n] + acc[ai][bj][m][n];
                        u32x2 w; w.x = pk2(o[0], o[1]); w.y = pk2(o[2], o[3]); *(u32x2*)(XB + (size_t)row * 1024 + c) = w;
                        ss += (o[0] * o[0] + o[1] * o[1]) + (o[2] * o[2] + o[3] * o[3]); }
                ss += __shfl_xor(ss, 16); ss += __shfl_xor(ss, 32);
                if (fq == 0) RSQ[(size_t)row * 16 + u.pn * 4 + wc] = ss; }
        }
    }
};
struct EpiFfnIn {
    static constexpr bool MID = false;
    static constexpr bool PERM = true;
    bf16_t* ACT; const float* RSQ;
    DI void operator()(const f32x4 (&acc)[2][2][4][2], const Unit& u, int wr, int wc, int fr, int fq) const {
        const int row0 = u.pm * 256 + wr * 64 + fr, c0 = u.pn * 128 + wc * 32 + 8 * fq;
        f32x4 pr[2][4];
#pragma unroll
        for (int ai = 0; ai < 2; ++ai)
#pragma unroll
            for (int m = 0; m < 4; ++m) pr[ai][m] = *(const f32x4*)(RSQ + (size_t)(row0 + ai * 128 + m * 16) * 16 + 4 * fq);
#pragma unroll
        for (int ai = 0; ai < 2; ++ai)
#pragma unroll
            for (int m = 0; m < 4; ++m) { const size_t row = (size_t)(row0 + ai * 128 + m * 16);
                const f32x4 q = pr[ai][m];
                float s = (q[0] + q[1]) + (q[2] + q[3]); s += __shfl_xor(s, 16); s += __shfl_xor(s, 32);
                const float rs = 1.0f / sqrtf(s * (1.0f / 1024.0f) + RMS_EPS);
                float o[8];
#pragma unroll
                for (int n = 0; n < 2; ++n)
#pragma unroll
                    for (int e = 0; e < 4; ++e) { const float gt = acc[ai][0][m][n][e] * rs, up = acc[ai][1][m][n][e] * rs; o[4 * n + e] = gt * fast_sigmoid(gt) * up; }
                u32x4 w; w.x = pk2(o[0], o[1]); w.y = pk2(o[2], o[3]); w.z = pk2(o[4], o[5]); w.w = pk2(o[6], o[7]);
                *(u32x4*)(ACT + row * DFF + c0) = w; }
    }
};

DI float wave_sum(float v) {
#pragma unroll
    for (int o = 1; o < 64; o <<= 1) v += __shfl_xor(v, o);
    return v;
}
DI void transpose_item(const float* W, int K, int N, int srccol0, const float* ks, bf16_t* WT, int dstrow0, int kb, LAS float* scr, int lane, int ldw = 0, int koff = 0) {
    if (ldw == 0) ldw = K;
    const int k0 = 64 * kb;
#pragma unroll 8
    for (int i = 0; i < 32; ++i) { const int kk = 2 * i + (lane >> 5); float v = W[(size_t)(k0 + kk) * N + srccol0 + (lane & 31)]; if (ks) v *= ks[k0 + kk]; scr[kk * 33 + (lane & 31)] = v; }
    asm volatile("s_waitcnt lgkmcnt(0)" ::: "memory");
    const int c = lane & 7;
#pragma unroll
    for (int j = 0; j < 4; ++j) { const int n = (lane >> 3) + 8 * j; const LAS float* s = scr + (8 * c) * 33 + n;
        u32x4 o; o.x = pk2(s[0 * 33], s[1 * 33]); o.y = pk2(s[2 * 33], s[3 * 33]); o.z = pk2(s[4 * 33], s[5 * 33]); o.w = pk2(s[6 * 33], s[7 * 33]);
        *(u32x4*)(WT + (size_t)(dstrow0 + n) * ldw + koff + k0 + 8 * c) = o; }
    asm volatile("s_waitcnt lgkmcnt(0)" ::: "memory");
}

struct Params { const float* in[14]; float* out; unsigned char* ws; int ph_lo, ph_hi; };

DI void p0_prologue(const Params& p, LAS unsigned char* lds, int gw, int NGW, int wave, int lane) {
    unsigned char* ws = p.ws;
    LAS float* scr = (LAS float*)(lds + wave * 16384);
    const float *w_in = p.in[3], *wa = p.in[7], *wc = p.in[8], *wout = p.in[9], *gffn = p.in[10], *wfi = p.in[11], *wfd = p.in[12];
    constexpr int I_IN = 16 * (NIN / 32), I_A = 8 * 32, I_C = 8 * 32, I_O = 16 * 32, I_FI = 16 * (2 * DFF / 32), I_FD = (DFF / 64) * 32;
    constexpr int NITEMS = I_IN + I_A + I_C + I_O + I_FI + I_FD;
    for (int it = gw; it < NITEMS; it += NGW) {
        int r = it;
        if (r < I_IN) { const int nblk = NIN / 32, kb = r / nblk, n0 = 32 * (r % nblk);
            const int src = n0 < 1024 ? n0 : (n0 < NMAIN ? n0 + 512 : n0 - NMAIN + 1024);
            transpose_item(w_in, D, NIN, src, nullptr, (bf16_t*)(ws + WS_WIN), n0, kb, scr, lane); continue; } r -= I_IN;
        if (r < I_A) { transpose_item(wa, DA, D, 32 * (r % 32), nullptr, (bf16_t*)(ws + WS_WA), 32 * (r % 32), r / 32, scr, lane, D, 0); continue; } r -= I_A;
        if (r < I_C) { transpose_item(wc, DA, D, 32 * (r % 32), nullptr, (bf16_t*)(ws + WS_WA), 32 * (r % 32), r / 32, scr, lane, D, DA); continue; } r -= I_C;
        if (r < I_O) { transpose_item(wout, D, D, 32 * (r % 32), nullptr, (bf16_t*)(ws + WS_WOUT), 32 * (r % 32), r / 32, scr, lane); continue; } r -= I_O;
        if (r < I_FI) { const int nblk = 2 * DFF / 32, kb = r / nblk, n0 = 32 * (r % nblk);
            const int pn = n0 >> 8, within = n0 & 255, src = (within >> 7) * DFF + 128 * pn + (within & 127);
            transpose_item(wfi, D, 2 * DFF, src, gffn, (bf16_t*)(ws + WS_WFI), n0, kb, scr, lane); continue; } r -= I_FI;
        transpose_item(wfd, DFF, D, 32 * (r % 32), nullptr, (bf16_t*)(ws + WS_WFD), 32 * (r % 32), r / 32, scr, lane);
    }
    if (gw < 4) { float* ig = (float*)(ws + WS_RSX) + M; const f32x4 gq = *((const f32x4*)p.in[2] + gw * 64 + lane); *((f32x4*)ig + gw * 64 + lane) = (f32x4){1.0f / gq[0], 1.0f / gq[1], 1.0f / gq[2], 1.0f / gq[3]}; }
    const float* gm = p.in[2];
    bf16_t* XN = (bf16_t*)(ws + WS_XN);
    f32x4 gv[4];
#pragma unroll
    for (int j = 0; j < 4; ++j) gv[j] = *((const f32x4*)gm + lane + 64 * j);
    for (int row = 2 * gw; row < M; row += 2 * NGW) {
        const float* xrow = row < MP ? p.in[0] + (size_t)row * D : p.in[1] + (size_t)(row - MP) * D;
        const f32x4* xr = (const f32x4*)xrow + lane;
        f32x4 v[2][4]; float s0 = 0.f, s1 = 0.f;
#pragma unroll
        for (int j = 0; j < 4; ++j) { v[0][j] = xr[64 * j]; v[1][j] = xr[256 + 64 * j]; }
#pragma unroll
        for (int j = 0; j < 4; ++j) { s0 += (v[0][j][0] * v[0][j][0] + v[0][j][1] * v[0][j][1]) + (v[0][j][2] * v[0][j][2] + v[0][j][3] * v[0][j][3]);
                                      s1 += (v[1][j][0] * v[1][j][0] + v[1][j][1] * v[1][j][1]) + (v[1][j][2] * v[1][j][2] + v[1][j][3] * v[1][j][3]); }
        const float rs0 = 1.0f / sqrtf(wave_sum(s0) * (1.0f / D) + RMS_EPS), rs1 = 1.0f / sqrtf(wave_sum(s1) * (1.0f / D) + RMS_EPS);
        u32x2* o8 = (u32x2*)(XN + (size_t)row * D) + lane;
#pragma unroll
        for (int j = 0; j < 4; ++j) { const f32x4 y0 = v[0][j] * rs0 * gv[j], y1 = v[1][j] * rs1 * gv[j];
            u32x2 w0, w1; w0.x = pk2(y0[0], y0[1]); w0.y = pk2(y0[2], y0[3]); w1.x = pk2(y1[0], y1[1]); w1.y = pk2(y1[2], y1[3]);
            o8[64 * j] = w0; o8[256 + 64 * j] = w1; }
        if (lane == 0) { float* rsx = (float*)(ws + WS_RSX); rsx[row] = rs0; rsx[row + 1] = rs1; }
    }
}

constexpr int TAB_PAD = 64;
constexpr int AT_RING_OFF = 16384, AT_SLOT_K = 40 * 144, AT_SLOT_V = 64 * 80, AT_SLOT = AT_SLOT_K + AT_SLOT_V, AT_NSLOT = 11;
static_assert(AT_RING_OFF + AT_NSLOT * AT_SLOT <= 139264, "attention ring fits below the LDS control words");
struct AtStage { const bf16_t* Kb; const bf16_t* VT; int b, h, cbase; };
DI void at_chunk(const AtStage& st, int c, int a, const bf16_t*& g, unsigned& l) {
    const int rowi = c / 640, cc = c - rowi * 640, row = a + rowi, slot = row % AT_NSLOT;
    if (cc < 320) { const int col = cc >> 3, part = cc & 7;
        g = st.Kb + ((size_t)st.b * SEQ + row * 64 + st.cbase + col) * 512 + st.h * 64 + part * 8; l = AT_RING_OFF + slot * AT_SLOT + col * 144 + part * 16; }
    else { const int c2 = cc - 320, d = c2 / 5, part = c2 - d * 5;
        g = st.VT + ((size_t)(st.b * 8 + st.h) * 128 + row) * 4096 + d * 64 + st.cbase + part * 8; l = AT_RING_OFF + slot * AT_SLOT + AT_SLOT_K + d * 80 + part * 16; }
}
template <int NB> DI void at_issue(const AtStage& st, int tid, int a, int n, u32x4 (&buf)[NB]) {
    const int total = n * 640;
#pragma unroll
    for (int k = 0; k < NB; ++k) { const int c = tid + k * 512; if (c < total) { const bf16_t* g; unsigned l; at_chunk(st, c, a, g, l); buf[k] = *(const u32x4*)g; } }
}
template <int NB> DI void at_write(const AtStage& st, LAS unsigned char* lds, int tid, int a, int n, const u32x4 (&buf)[NB]) {
    const int total = n * 640;
#pragma unroll
    for (int k = 0; k < NB; ++k) { const int c = tid + k * 512; if (c < total) { const bf16_t* g; unsigned l; at_chunk(st, c, a, g, l); *(LAS u32x4*)(lds + l) = buf[k]; } }
}
DI int clamp_i(int v, int lo, int hi) { return v < lo ? lo : (v > hi ? hi : v); }
DI void p2_attention(const Params& p, LAS unsigned char* lds, int tid, int wave, int lane, int G, int bx) {
    unsigned char* ws = p.ws;
    const bf16_t* Q = (const bf16_t*)(ws + WS_Q);
    bf16_t* AC = (bf16_t*)(ws + WS_AC);
    const float* rpb = p.in[5];
    LAS float* tab = (LAS float*)lds + TAB_PAD;
    for (int i = tid; i < 8 * 15 * 32 + 2 * TAB_PAD; i += 512) { const int k = i - TAB_PAD; float v = 0.f;
        if (k >= 0 && k < 8 * 15 * 32) { const int h = k / 480, rem = k % 480, ri = rem >> 5, ci = rem & 31; if (ci < 31) v = rpb[(h * 15 + ri) * 31 + ci] * LOG2E; }
        ((LAS float*)lds)[i] = v; }
    __syncthreads();
    const int qi = lane & 15, mq = lane >> 4, jj = wave & 1, rr = wave >> 1;
    constexpr int NUNITS = 10 * 8 * 2 * 8;
    const int per = (NUNITS + G - 1) / G;
    for (int un = bx * per; un < (bx + 1) * per && un < NUNITS; ++un) {
        const int band = un & 7, ch = (un >> 3) & 1, bh = un >> 4, b = bh >> 3, h = bh & 7;
        const int j = 2 * ch + jj, cbase = ch ? 24 : 0, kcol0 = cbase + 8 * jj, qcol = 16 * j + qi;
        const int cstart = clamp_i(qcol - 8, 0, 48), t0 = kcol0 + 4 * mq - cstart, cidx0 = kcol0 + 4 * mq - qcol + 15;
        bool v0[4];
#pragma unroll
        for (int e = 0; e < 4; ++e) v0[e] = (t0 + e >= 0);
        AtStage st{(const bf16_t*)(ws + WS_K), (const bf16_t*)(ws + WS_VT), b, h, cbase};
        const int r0 = band * 16;
        int hi = clamp_i(r0 - 1, 0, 120) + 7;
        bf16x8 qf[2];
        { const int lo = clamp_i(r0 - 4, 0, 120);
          for (int a = lo; a <= hi; a += 4) { const int n = hi - a + 1 < 4 ? hi - a + 1 : 4;
              u32x4 buf[5]; at_issue<5>(st, tid, a, n, buf); at_write<5>(st, lds, tid, a, n, buf); }
          const size_t qtok = (size_t)b * SEQ + (r0 + rr) * 64 + qcol;
#pragma unroll
          for (int ks = 0; ks < 2; ++ks) qf[ks] = *(const bf16x8*)(Q + qtok * 512 + h * 64 + ks * 32 + mq * 8); }
        __syncthreads();
        for (int it = 0; it < 4; ++it) {
            const int r = r0 + 4 * it, q = r + rr;
            u32x4 pf[5]; bf16x8 qn[2]; int nhi = hi;
            if (it < 3) { nhi = clamp_i(r + 3, 0, 120) + 7;
                at_issue<5>(st, tid, hi + 1, nhi - hi, pf);
                const size_t qtn = (size_t)b * SEQ + (q + 4) * 64 + qcol;
#pragma unroll
                for (int ks = 0; ks < 2; ++ks) qn[ks] = *(const bf16x8*)(Q + qtn * 512 + h * 64 + ks * 32 + mq * 8); }
            __builtin_amdgcn_sched_barrier(0);
            const int rs = clamp_i(q - 4, 0, 120);
            const size_t qtok = (size_t)b * SEQ + q * 64 + qcol;
            f32x4 s[8][2];
            { int slot = rs % AT_NSLOT;
#pragma unroll
              for (int w = 0; w < 8; ++w) {
                const LAS unsigned char* kb = lds + AT_RING_OFF + slot * AT_SLOT + (8 * jj + qi) * 144 + mq * 16;
#pragma unroll
                for (int cb = 0; cb < 2; ++cb) {
                    const bf16x8 k0 = *(const LAS bf16x8*)(kb + cb * 16 * 144), k1 = *(const LAS bf16x8*)(kb + cb * 16 * 144 + 64);
                    f32x4 a = __builtin_amdgcn_mfma_f32_16x16x32_bf16(k0, qf[0], (f32x4){0.f, 0.f, 0.f, 0.f}, 0, 0, 0);
                    s[w][cb] = __builtin_amdgcn_mfma_f32_16x16x32_bf16(k1, qf[1], a, 0, 0, 0);
                }
                slot = slot + 1 == AT_NSLOT ? 0 : slot + 1;
              } }
            const LAS float* tb = tab + h * 480 + (rs - q + 7) * 32 + cidx0;
            float mx = -1e30f;
#pragma unroll
            for (int w = 0; w < 8; ++w)
#pragma unroll
                for (int cb = 0; cb < 2; ++cb)
#pragma unroll
                    for (int e = 0; e < 4; ++e) { const bool ok = cb == 0 ? v0[e] : !v0[e];
                        const float x = ok ? s[w][cb][e] + tb[32 * w + 16 * cb + e] : -1e30f; s[w][cb][e] = x; mx = fmaxf(mx, x); }
            mx = fmaxf(mx, __shfl_xor(mx, 16)); mx = fmaxf(mx, __shfl_xor(mx, 32));
            float sum = 0.f;
#pragma unroll
            for (int w = 0; w < 8; ++w)
#pragma unroll
                for (int cb = 0; cb < 2; ++cb)
#pragma unroll
                    for (int e = 0; e < 4; ++e) { const float pe = __builtin_amdgcn_exp2f(s[w][cb][e] - mx); s[w][cb][e] = pe; sum += pe; }
            sum += __shfl_xor(sum, 16); sum += __shfl_xor(sum, 32);
            const float inv = 1.0f / sum;
            f32x4 o[4];
#pragma unroll
            for (int db = 0; db < 4; ++db) o[db] = (f32x4){0.f, 0.f, 0.f, 0.f};
            { int slot = rs % AT_NSLOT;
#pragma unroll
              for (int w = 0; w < 8; ++w) {
                u32x4 pw; pw.x = pk2(s[w][0][0], s[w][0][1]); pw.y = pk2(s[w][0][2], s[w][0][3]); pw.z = pk2(s[w][1][0], s[w][1][1]); pw.w = pk2(s[w][1][2], s[w][1][3]);
                const bf16x8 pfr = __builtin_bit_cast(bf16x8, pw);
                const LAS unsigned char* vb = lds + AT_RING_OFF + slot * AT_SLOT + AT_SLOT_K + qi * 80 + (8 * jj + 4 * mq) * 2;
#pragma unroll
                for (int db = 0; db < 4; ++db) {
                    const u32x2 lo2 = *(const LAS u32x2*)(vb + db * 16 * 80), hi2 = *(const LAS u32x2*)(vb + db * 16 * 80 + 32);
                    u32x4 vw; vw.x = lo2.x; vw.y = lo2.y; vw.z = hi2.x; vw.w = hi2.y;
                    o[db] = __builtin_amdgcn_mfma_f32_16x16x32_bf16(__builtin_bit_cast(bf16x8, vw), pfr, o[db], 0, 0, 0);
                }
                slot = slot + 1 == AT_NSLOT ? 0 : slot + 1;
              } }
#pragma unroll
            for (int db = 0; db < 4; ++db) { const f32x4 y = o[db] * inv; u32x2 w2; w2.x = pk2(y[0], y[1]); w2.y = pk2(y[2], y[3]);
                *(u32x2*)(AC + qtok * 1024 + h * 64 + db * 16 + 4 * mq) = w2; }
            __syncthreads();
            if (it < 3) { at_write<5>(st, lds, tid, hi + 1, nhi - hi, pf); hi = nhi; qf[0] = qn[0]; qf[1] = qn[1]; }
            __syncthreads();
        }
    }
}
DI void p2_conv(const Params& p, int gtid, int nthreads) {
    unsigned char* ws = p.ws;
    const bf16_t* UBC = (const bf16_t*)(ws + WS_UBC); bf16_t* AC = (bf16_t*)(ws + WS_AC);
    const float* cw = p.in[6];
    const int c8 = (gtid & 63) * 8;
    float wt[3][8];
#pragma unroll
    for (int k = 0; k < 3; ++k) { const f32x4 a = *(const f32x4*)(cw + k * 512 + c8), b = *(const f32x4*)(cw + k * 512 + c8 + 4);
#pragma unroll
        for (int e = 0; e < 4; ++e) { wt[k][e] = a[e]; wt[k][4 + e] = b[e]; } }
    for (int idx = gtid; idx < (M / 4) * 64; idx += nthreads) {
        const int run = idx >> 6, tok0 = run * 4, t = tok0 & (SEQ - 1);
        const bf16_t* rp = UBC + (size_t)tok0 * 1536 + c8;
        const u32x4 zero = {0u, 0u, 0u, 0u};
        u32x4 uu[6], gg[6], bg[4];
#pragma unroll
        for (int i = 0; i < 6; ++i) { const bool ok = !((i == 0 && t == 0) || (i == 5 && t == SEQ - 4));
            uu[i] = ok ? *(const u32x4*)(rp + (ptrdiff_t)(i - 1) * 1536) : zero; gg[i] = ok ? *(const u32x4*)(rp + (ptrdiff_t)(i - 1) * 1536 + 1024) : zero; }
#pragma unroll
        for (int i = 0; i < 4; ++i) bg[i] = *(const u32x4*)(rp + (size_t)i * 1536 + 512);
        float z[6][8];
#pragma unroll
        for (int i = 0; i < 6; ++i)
#pragma unroll
            for (int e = 0; e < 4; ++e) { z[i][2 * e] = bf_lo(uu[i][e]) * bf_lo(gg[i][e]); z[i][2 * e + 1] = bf_hi(uu[i][e]) * bf_hi(gg[i][e]); }
#pragma unroll
        for (int i = 0; i < 4; ++i) { float o[8];
#pragma unroll
            for (int e = 0; e < 4; ++e) {
                o[2 * e]     = bf_lo(bg[i][e]) * (wt[0][2 * e] * z[i][2 * e] + wt[1][2 * e] * z[i + 1][2 * e] + wt[2][2 * e] * z[i + 2][2 * e]);
                o[2 * e + 1] = bf_hi(bg[i][e]) * (wt[0][2 * e + 1] * z[i][2 * e + 1] + wt[1][2 * e + 1] * z[i + 1][2 * e + 1] + wt[2][2 * e + 1] * z[i + 2][2 * e + 1]); }
            u32x4 w; w.x = pk2(o[0], o[1]); w.y = pk2(o[2], o[3]); w.z = pk2(o[4], o[5]); w.w = pk2(o[6], o[7]);
            *(u32x4*)(AC + (size_t)(tok0 + i) * 1024 + 512 + c8) = w; }
    }
}

DI void p7_final(const Params& p, int gw, int NGW, int lane) {
    const float* RSQ = (const float*)(p.ws + WS_RSQ2); const float* gf = p.in[13]; const bf16_t* XB = (const bf16_t*)(p.ws + WS_X1B);
    f32x4 gv[2][2];
#pragma unroll
    for (int hh = 0; hh < 2; ++hh) { gv[hh][0] = *(const f32x4*)(gf + hh * 512 + 8 * lane); gv[hh][1] = *(const f32x4*)(gf + hh * 512 + 8 * lane + 4); }
    for (int row = 2 * gw; row < M; row += 2 * NGW) {
        float s = lane < 32 ? RSQ[(size_t)row * 16 + lane] : 0.f;
#pragma unroll
        for (int o = 1; o < 16; o <<= 1) s += __shfl_xor(s, o);
        const float sa = __shfl(s, 0), sb = __shfl(s, 16);
        float rs[2]; rs[0] = 1.0f / sqrtf(sa * (1.0f / D) + RMS_EPS); rs[1] = 1.0f / sqrtf(sb * (1.0f / D) + RMS_EPS);
        u32x4 v[2][2];
#pragma unroll
        for (int rr = 0; rr < 2; ++rr)
#pragma unroll
            for (int hh = 0; hh < 2; ++hh) v[rr][hh] = *(const u32x4*)(XB + (size_t)(row + rr) * D + hh * 512 + 8 * lane);
#pragma unroll
        for (int rr = 0; rr < 2; ++rr)
#pragma unroll
            for (int hh = 0; hh < 2; ++hh) { const u32x4 w = v[rr][hh]; float* op = p.out + (size_t)(row + rr) * D + hh * 512 + 8 * lane;
                *(f32x4*)op = (f32x4){bf_lo(w.x), bf_hi(w.x), bf_lo(w.y), bf_hi(w.y)} * rs[rr] * gv[hh][0];
                *(f32x4*)(op + 4) = (f32x4){bf_lo(w.z), bf_hi(w.z), bf_lo(w.w), bf_hi(w.w)} * rs[rr] * gv[hh][1]; }
    }
}

#define XB_TMO      128
#define XB_XCNT(j)  (256  + 64 * (j))
#define XB_XSUB(j)  (1280 + 64 * (j))
#define XB_XGEN(j)  (2304 + 64 * (j))
#define XB_TOP      3328
#define XB_TOPGEN   3392
#define XCD_BAR_WORDS 3456
#define XB_SPIN_CAP (1u << 18)
DI unsigned xb_ld(unsigned* p)              { return __hip_atomic_load(p, __ATOMIC_RELAXED, __HIP_MEMORY_SCOPE_AGENT); }
DI unsigned xb_add(unsigned* p, unsigned v) { return __hip_atomic_fetch_add(p, v, __ATOMIC_RELAXED, __HIP_MEMORY_SCOPE_AGENT); }
DI unsigned xb_xcc_id() { return (unsigned)__builtin_amdgcn_s_getreg((3 << 11) | 20) & 0xFu; }
#define XB_SPIN(cond, bar) do { unsigned _sp = 0; while (cond) { __builtin_amdgcn_s_sleep(1); \
    if ((++_sp & 255u) == 0u) { if (xb_ld(&(bar)[XB_TMO])) break; if (_sp > XB_SPIN_CAP) { atomicAdd(&(bar)[XB_TMO], 1u); break; } } } } while (0)
struct XcdBarrier { unsigned* bar; unsigned x; volatile LAS unsigned* st; };
DI XcdBarrier xcd_barrier_post(unsigned* bar, volatile LAS unsigned* st) {
    XcdBarrier b; b.bar = bar; b.x = xb_xcc_id(); b.st = st;
    if (threadIdx.x == 0) (void)xb_add(&bar[XB_XCNT(b.x)], 1u);
    return b;
}
DI void xcd_barrier_complete(unsigned* bar, unsigned x, unsigned& nloc, unsigned& nx) {
    const unsigned G = gridDim.x * gridDim.y * gridDim.z;
    unsigned sum, cnt, mine, sp = 0u;
    for (;;) {
        sum = 0u; cnt = 0u; mine = 0u;
#pragma unroll
        for (unsigned j = 0; j < 16; ++j) { const unsigned c = xb_ld(&bar[XB_XCNT(j)]); sum += c; cnt += (c > 0u) ? 1u : 0u; mine = (j == x) ? c : mine; }
        if (sum == G) break;
        __builtin_amdgcn_s_sleep(1);
        if ((++sp & 255u) == 0u) { if (xb_ld(&bar[XB_TMO])) break; if (sp > XB_SPIN_CAP) { atomicAdd(&bar[XB_TMO], 1u); break; } }
    }
    nloc = mine > 0u ? mine : 1u; nx = cnt > 0u ? cnt : 1u;
}
DI void xcd_barrier(const XcdBarrier& b) {
    asm volatile("s_waitcnt vmcnt(0)" ::: "memory");
    __syncthreads();
    if (threadIdx.x == 0) {
        unsigned* bar = b.bar;
        __builtin_amdgcn_s_waitcnt(0);
        unsigned nloc = b.st[0], nx = b.st[1];
        if (nloc == 0u) { xcd_barrier_complete(bar, b.x, nloc, nx); b.st[0] = nloc; b.st[1] = nx; }
        const unsigned old = xb_add(&bar[XB_XSUB(b.x)], 1u);
        const unsigned gen = old / nloc;
        if (old + 1u == (gen + 1u) * nloc) {
            __builtin_amdgcn_fence(__ATOMIC_RELEASE, "agent");
            asm volatile("s_waitcnt vmcnt(0)" ::: "memory");
            const unsigned og = xb_add(&bar[XB_TOP], 1u);
            const unsigned tg = og / nx;
            if (og + 1u == (tg + 1u) * nx) xb_add(&bar[XB_TOPGEN], 1u);
            else XB_SPIN(xb_ld(&bar[XB_TOPGEN]) == tg, bar);
            __builtin_amdgcn_fence(__ATOMIC_ACQUIRE, "agent");
            xb_add(&bar[XB_XGEN(b.x)], 1u);
            asm volatile("s_waitcnt vmcnt(0)" ::: "memory");
        } else {
            XB_SPIN(xb_ld(&bar[XB_XGEN(b.x)]) == gen, bar);
            __builtin_amdgcn_fence(__ATOMIC_ACQUIRE, "agent");
            asm volatile("s_waitcnt vmcnt(0)" ::: "memory");
        }
    }
    __syncthreads();
}

__global__ void __launch_bounds__(512, 2) fwd_megakernel(Params p) {
    extern __shared__ __attribute__((aligned(16))) unsigned char lds_raw[];
    LAS unsigned char* lds = (LAS unsigned char*)lds_raw;
    cg::grid_group grid = cg::this_grid();
    const int tid = threadIdx.x, lane = tid & 63, wave = __builtin_amdgcn_readfirstlane(tid >> 6);
    const int G = gridDim.x, bx = blockIdx.x;
    const int gw = bx * 8 + wave, NGW = G * 8;
    unsigned char* ws = p.ws;
    const int lo = p.ph_lo, hi = p.ph_hi;
#define IN(k) (lo <= (k) && (k) < hi)
#define SEAM(k) do { if (IN(k) && IN((k) + 1)) xcd_barrier(xbar); } while (0)
    volatile LAS unsigned* misc = (volatile LAS unsigned*)(lds + MISC_OFF);
    if (tid < 16) misc[tid] = 0u;
    __syncthreads();
    const XcdBarrier xbar = xcd_barrier_post((unsigned*)ws, misc + 8);
    bf16_t* XN = (bf16_t*)(ws + WS_XN); bf16_t* Wt_in = (bf16_t*)(ws + WS_WIN);

    if (IN(0)) { p0_prologue(p, lds, gw, NGW, wave, lane); }
    SEAM(0);
    if (IN(1)) {
        { pg8::Gemm g{XN, Wt_in, M, NMAIN, D, D}; pg8::StaticOrder S; S.init(M, NMAIN, G, bx);
          EpiProj E{(bf16_t*)(ws + WS_Q), (bf16_t*)(ws + WS_K), (bf16_t*)(ws + WS_UBC), (bf16_t*)(ws + WS_G), p.in[4]};
          pg8::gemm_phase<EpiProj, pg8::StaticOrder, true>(lds, g, S, E); }
        { pg8::Gemm g{Wt_in + (size_t)NMAIN * D, XN, DA, M, D, D}; pg8::VtOrder S{G, bx};
          EpiVT E{(bf16_t*)(ws + WS_VT)};
          pg8::gemm_phase<EpiVT, pg8::VtOrder, true>(lds, g, S, E); }
    }
    SEAM(1);
    if (IN(2)) { p2_conv(p, bx * 512 + tid, G * 512); p2_attention(p, lds, tid, wave, lane, G, bx); __syncthreads(); }
    SEAM(2);
    if (IN(3)) {
        pg8::Gemm g{(bf16_t*)(ws + WS_AC), (bf16_t*)(ws + WS_WA), M, D, D, D}; pg8::StaticOrder S; S.init(M, D, G, bx);
        EpiMerge E{(bf16_t*)(ws + WS_MG), (const unsigned char*)(ws + WS_G)};
        pg8::gemm_phase<EpiMerge, pg8::StaticOrder, true>(lds, g, S, E);
    }
    SEAM(3);
    if (IN(4)) {
        pg8::Gemm g{(bf16_t*)(ws + WS_MG), (bf16_t*)(ws + WS_WOUT), M, D, D, D}; pg8::StaticOrder S; S.init(M, D, G, bx);
        EpiResid E{XN, (const float*)(ws + WS_RSX), (const float*)(ws + WS_RSX) + M, (bf16_t*)(ws + WS_X1B), (float*)(ws + WS_RSQ1), 0};
        pg8::gemm_phase<EpiResid, pg8::StaticOrder, true>(lds, g, S, E);
    }
    SEAM(4);
    if (IN(5)) {
        pg8::Gemm g{(bf16_t*)(ws + WS_X1B), (bf16_t*)(ws + WS_WFI), M, 2 * DFF, D, D}; pg8::StaticOrder S; S.init(M, 2 * DFF, G, bx);
        EpiFfnIn E{(bf16_t*)(ws + WS_ACT), (const float*)(ws + WS_RSQ1)};
        pg8::gemm_phase<EpiFfnIn, pg8::StaticOrder, true>(lds, g, S, E);
    }
    SEAM(5);
    if (IN(6)) {
        pg8::Gemm g{(bf16_t*)(ws + WS_ACT), (bf16_t*)(ws + WS_WFD), M, D, DFF, DFF}; pg8::StaticOrder S; S.init(M, D, G, bx);
        EpiResid E{nullptr, nullptr, nullptr, (bf16_t*)(ws + WS_X1B), (float*)(ws + WS_RSQ2), 1};
        pg8::gemm_phase<EpiResid, pg8::StaticOrder, true>(lds, g, S, E);
    }
    SEAM(6);
    if (IN(7)) { p7_final(p, gw, NGW, lane); }
    if (p.ph_hi > 1000) grid.sync();
#undef IN
#undef SEAM
}

extern "C" void kernel_launch(void* const* d_in, const int* in_sizes, int n_in, void* d_out, int out_size, void* d_ws, size_t ws_size, hipStream_t stream) {
    static int grid_blocks = 0;
    if (grid_blocks == 0) {
        if (n_in != 14 || in_sizes[0] != MP * D || in_sizes[1] != (M - MP) * D || out_size != M * D || ws_size < WS_END) {
            fprintf(stderr, "kernel_launch: unexpected shapes / workspace (n_in %d, ws %zu); nothing launched\n", n_in, ws_size); grid_blocks = -1; return; }
        int dev = 0, cus = 0, per_cu = 0;
        (void)hipGetDevice(&dev);
        (void)hipDeviceGetAttribute(&cus, hipDeviceAttributeMultiprocessorCount, dev);
        (void)hipFuncSetAttribute((const void*)fwd_megakernel, hipFuncAttributeMaxDynamicSharedMemorySize, LDS_BYTES);
        (void)hipOccupancyMaxActiveBlocksPerMultiprocessor(&per_cu, (const void*)fwd_megakernel, 512, LDS_BYTES);
        (void)hipGetLastError();
        if (per_cu < 1) per_cu = 1;
        grid_blocks = cus * per_cu;
    }
    if (grid_blocks < 0) return;
    if (hipMemsetAsync(d_ws, 0, 16384, stream) != hipSuccess) { fprintf(stderr, "kernel_launch: memset of the barrier words failed\n"); return; }
    Params p{};
    for (int i = 0; i < 14; ++i) p.in[i] = (const float*)d_in[i];
    p.out = (float*)d_out; p.ws = (unsigned char*)d_ws; p.ph_lo = 0; p.ph_hi = 8;
    void* args[] = {&p};
    hipError_t e = hipLaunchCooperativeKernel((const void*)fwd_megakernel, dim3(grid_blocks), dim3(512), args, LDS_BYTES, stream);
    if (e != hipSuccess) fprintf(stderr, "cooperative launch failed: %s (grid %d)\n", hipGetErrorString(e), grid_blocks);
}
```
